# Optimizing an MI355X kernel written in HIP

```python
import jax, jax.numpy as jnp
from jax import lax
import numpy as np

D_MODEL = 1024
BATCH = 4
SEQ = 8192
DEPTH = 1

CONV_DIM = 1024
CONV_WIDTH = 31
GLA_HEADS = 4
GLA_DK = D_MODEL // 2
GLA_DV = D_MODEL
GLA_HEAD_K = GLA_DK // GLA_HEADS
GLA_HEAD_V = GLA_DV // GLA_HEADS
GLA_GATE_RANK = 16
GLA_GATE_TAU = 16.0
GLA_CHUNK = 64
N_BRANCH = 2
D_FF = 4 * D_MODEL
EPS = 1e-6
IN_SIZES = (2 * CONV_DIM, GLA_DK, GLA_DK, GLA_DV, GLA_DV, GLA_GATE_RANK, N_BRANCH * D_MODEL)
D_IN = 2 * CONV_DIM + 2 * GLA_DK + 2 * GLA_DV + GLA_GATE_RANK + N_BRANCH * D_MODEL

kernel_name = "hybrid_conformer_conv_gla_block"


def rms_norm(x, g):
    xf = x.astype(jnp.float32)
    y = xf * lax.rsqrt(jnp.mean(xf * xf, axis=-1, keepdims=True) + EPS)
    return (y * g.astype(jnp.float32)).astype(x.dtype)


def layer_norm(x, g, b):
    xf = x.astype(jnp.float32)
    mu = jnp.mean(xf, axis=-1, keepdims=True)
    var = jnp.mean(jnp.square(xf - mu), axis=-1, keepdims=True)
    y = (xf - mu) * lax.rsqrt(var + EPS)
    return (y * g.astype(jnp.float32) + b.astype(jnp.float32)).astype(x.dtype)


def causal_depthwise_conv(u, w, bias):
    K = w.shape[0]
    u_pad = jnp.pad(u, ((0, 0), (K - 1, 0), (0, 0)))
    y = lax.conv_general_dilated(
        u_pad, w[:, None, :].astype(u.dtype), window_strides=(1,), padding='VALID',
        dimension_numbers=('NWC', 'WIO', 'NWC'), feature_group_count=u.shape[-1])
    return y + bias.astype(u.dtype)


def gla_chunked(q, k, v, log_a):
    B, S, H, dk = q.shape
    dv = v.shape[-1]
    C = GLA_CHUNK
    N = S // C

    def to_chunks(t):
        return t.astype(jnp.float32).reshape(B, N, C, H, t.shape[-1]).transpose(0, 3, 1, 2, 4)

    q, k, v, log_a = to_chunks(q), to_chunks(k), to_chunks(v), to_chunks(log_a)
    q = q * (dk ** -0.5)
    b = jnp.cumsum(log_a, axis=3)
    b_last = b[:, :, :, -1:, :]
    chunk_kv = jnp.einsum('bhncd,bhnce->bhnde', k * jnp.exp(b_last - b), v)
    chunk_decay = jnp.exp(b_last[:, :, :, 0, :])

    def step(state, inp):
        decay, kv = inp
        return decay[..., None] * state + kv, state

    init = jnp.zeros((B, H, dk, dv), jnp.float32)
    _, states = lax.scan(step, init, (chunk_decay.transpose(2, 0, 1, 3),
                                      chunk_kv.transpose(2, 0, 1, 3, 4)))
    states = states.transpose(1, 2, 0, 3, 4)
    o_inter = jnp.einsum('bhncd,bhnde->bhnce', q * jnp.exp(b), states)
    ref = b[:, :, :, C // 2:C // 2 + 1, :]
    scores = jnp.einsum('bhnid,bhnjd->bhnij', q * jnp.exp(b - ref), k * jnp.exp(ref - b))
    mask = jnp.tril(jnp.ones((C, C), dtype=bool))
    scores = jnp.where(mask, scores, 0.0)
    o_intra = jnp.einsum('bhnij,bhnje->bhnie', scores, v)
    o = o_inter + o_intra
    return o.transpose(0, 2, 3, 1, 4).reshape(B, S, H, dv)


def setup_inputs(seed: int = 0) -> dict:
    key = jax.random.key(seed)
    ks = jax.random.split(key, 24)

    def nrm(k, shape, scale):
        return jax.random.normal(k, shape, jnp.float32) * scale

    L = DEPTH
    return {
        "x": nrm(ks[0], (BATCH, SEQ, D_MODEL), 1.0),
        "c": nrm(ks[1], (BATCH, D_MODEL), 1.0),
        "w_ada": nrm(ks[2], (L, D_MODEL, 6 * D_MODEL), 0.5 * D_MODEL ** -0.5),
        "b_ada": nrm(ks[3], (L, 6 * D_MODEL), 0.02),
        "g_mix": 1.0 + nrm(ks[4], (L, D_MODEL), 0.02),
        "w_in": nrm(ks[5], (L, D_MODEL, D_IN), D_MODEL ** -0.5),
        "b_glu": nrm(ks[6], (L, 2 * CONV_DIM), 0.02),
        "w_dw": nrm(ks[7], (L, CONV_WIDTH, CONV_DIM), CONV_WIDTH ** -0.5),
        "b_dw": nrm(ks[8], (L, CONV_DIM), 0.02),
        "g_cln": 1.0 + nrm(ks[9], (L, CONV_DIM), 0.02),
        "b_cln": nrm(ks[10], (L, CONV_DIM), 0.02),
        "w_conv_out": nrm(ks[11], (L, CONV_DIM, D_MODEL), CONV_DIM ** -0.5),
        "b_conv_out": nrm(ks[12], (L, D_MODEL), 0.02),
        "w_a2": nrm(ks[13], (L, GLA_GATE_RANK, GLA_DK), GLA_GATE_RANK ** -0.5),
        "b_a2": nrm(ks[14], (L, GLA_DK), 0.1),
        "g_gla": 1.0 + nrm(ks[15], (L, GLA_DV), 0.02),
        "w_gla_out": nrm(ks[16], (L, GLA_DV, D_MODEL), GLA_DV ** -0.5),
        "w_o": nrm(ks[17], (L, D_MODEL, D_MODEL), D_MODEL ** -0.5),
        "g_mlp": 1.0 + nrm(ks[18], (L, D_MODEL), 0.02),
        "w_ff1": nrm(ks[19], (L, D_MODEL, D_FF), D_MODEL ** -0.5),
        "w_ff2": nrm(ks[20], (L, D_FF, D_MODEL), D_FF ** -0.5),
        "g_final": 1.0 + nrm(ks[21], (D_MODEL,), 0.02),
    }


def reference(x, c, w_ada, b_ada, g_mix, w_in, b_glu, w_dw, b_dw, g_cln, b_cln,
              w_conv_out, b_conv_out, w_a2, b_a2, g_gla, w_gla_out, w_o,
              g_mlp, w_ff1, w_ff2, g_final):
    B, S, D = x.shape
    split_idx = list(np.cumsum(IN_SIZES)[:-1])
    for l in range(DEPTH):
        mod = jax.nn.silu(c) @ w_ada[l] + b_ada[l]
        sh1, sc1, gt1, sh2, sc2, gt2 = [m[:, None, :] for m in jnp.split(mod, 6, axis=-1)]

        h = rms_norm(x, g_mix[l]) * (1.0 + sc1) + sh1
        p = h @ w_in[l]
        p_glu, p_q, p_k, p_v, p_g, p_lr, p_gate = jnp.split(p, split_idx, axis=-1)

        u_a, u_b = jnp.split(p_glu + b_glu[l], 2, axis=-1)
        u = u_a * jax.nn.sigmoid(u_b)
        u = causal_depthwise_conv(u, w_dw[l], b_dw[l])
        u = jax.nn.silu(layer_norm(u, g_cln[l], b_cln[l]))
        y_conv = u @ w_conv_out[l] + b_conv_out[l]

        log_a = jax.nn.log_sigmoid(p_lr @ w_a2[l] + b_a2[l]) / GLA_GATE_TAU
        q = p_q.reshape(B, S, GLA_HEADS, GLA_HEAD_K)
        k = p_k.reshape(B, S, GLA_HEADS, GLA_HEAD_K)
        v = p_v.reshape(B, S, GLA_HEADS, GLA_HEAD_V)
        la = log_a.reshape(B, S, GLA_HEADS, GLA_HEAD_K)
        o = gla_chunked(q, k, v, la)
        o = rms_norm(o, g_gla[l].reshape(GLA_HEADS, GLA_HEAD_V)).astype(x.dtype)
        o = o.reshape(B, S, GLA_DV) * jax.nn.silu(p_g)
        y_gla = o @ w_gla_out[l]

        gate_conv, gate_gla = jnp.split(jax.nn.sigmoid(p_gate), 2, axis=-1)
        merged = gate_conv * y_conv + gate_gla * y_gla
        x = x + gt1 * (merged @ w_o[l])

        h2 = rms_norm(x, g_mlp[l]) * (1.0 + sc2) + sh2
        f = jnp.square(jax.nn.relu(h2 @ w_ff1[l])) @ w_ff2[l]
        x = x + gt2 * f
    return rms_norm(x, g_final)
```

```cpp
#include <hip/hip_runtime.h>
#include <cstdio>
#include <cstdint>
#include <utility>
namespace pg8 {
#define PG8_LAS __attribute__((address_space(3)))
typedef unsigned short bf16_t;
typedef short bf16x8 __attribute__((ext_vector_type(8)));
typedef float f32x4 __attribute__((ext_vector_type(4)));
typedef unsigned u32x4 __attribute__((ext_vector_type(4)));
constexpr int BM = 256, BK = 64, HALF = 128, HTB = HALF * BK * 2  , STAGE_BYTES = 8 * HTB, NXCD = 8, WGM = 8;

__host__ __device__ __forceinline__ int lds_byte(int r, int c) { const int st = (r >> 4) * 2 + (c >> 5), rr = r & 15, cc = c & 31, ob = rr * 64 + cc * 2; return st * 1024 + (ob ^ (((ob >> 9) & 1) << 5)); }
__host__ __device__ __forceinline__ void stage_rc(int b, int& R, int& C) { const int st = b / 1024, sb = b % 1024, swz = sb ^ (((sb >> 9) & 1) << 5); R = (st >> 1) * 16 + swz / 64; C = (st & 1) * 32 + (swz % 64) / 2; }
__host__ __device__ __forceinline__ int perm32(int rho) { const int n = rho >> 4, i = rho & 15; return 8 * (i >> 2) + 4 * n + (i & 3); }

struct Unit { int pm, pn; };
struct Gemm { const bf16_t* A; const bf16_t* Bt; int M, N, K; };

struct StaticOrder {
    int nM, nN, nwg, G, c;
    __host__ __device__ void init(int M, int N, int G_, int c_) { nM = M / BM; nN = N / BM; nwg = nM * nN; G = G_; c = c_; }
    __host__ __device__ bool next(int i, Unit& u) const {
        const long L = (long)i * G + c; if (L >= nwg) return false;
        int wgid = (int)L; { const int q = nwg / NXCD, r = nwg % NXCD, xcd = wgid % NXCD, off = wgid / NXCD; wgid = (xcd < r ? xcd * (q + 1) : r * (q + 1) + (xcd - r) * q) + off; }
        const int nig = WGM * nN, gid = wgid / nig, fm = gid * WGM, gsz = (nM - fm) < WGM ? (nM - fm) : WGM;
        u.pm = fm + ((wgid % nig) % gsz); u.pn = (wgid % nig) / gsz; return true;
    }
    __device__ __forceinline__ void a_ready(const Unit&) const {}
    __device__ __forceinline__ void done(const Unit&) const {}
};


typedef float f32x2 __attribute__((ext_vector_type(2)));
typedef __bf16 bf16x2_t __attribute__((ext_vector_type(2)));
__device__ __forceinline__ unsigned pk2(float lo, float hi) { f32x2 v = {lo, hi}; return __builtin_bit_cast(unsigned, __builtin_convertvector(v, bf16x2_t)); }
__device__ __forceinline__ float bf_lo(unsigned u) { return __uint_as_float(u << 16); }
__device__ __forceinline__ float bf_hi(unsigned u) { return __uint_as_float(u & 0xffff0000u); }
__device__ __forceinline__ float sigm(float x) { return __builtin_amdgcn_rcpf(1.0f + __expf(-x)); }
__device__ __forceinline__ void st8(bf16_t* p, f32x4 v0, f32x4 v1) { u32x4 w; w.x = pk2(v0[0], v0[1]); w.y = pk2(v0[2], v0[3]); w.z = pk2(v1[0], v1[1]); w.w = pk2(v1[2], v1[3]); *(u32x4*)p = w; }
__device__ __forceinline__ void ld8(const bf16_t* p, f32x4& v0, f32x4& v1) { const u32x4 w = *(const u32x4*)p; v0 = (f32x4){bf_lo(w.x), bf_hi(w.x), bf_lo(w.y), bf_hi(w.y)}; v1 = (f32x4){bf_lo(w.z), bf_hi(w.z), bf_lo(w.w), bf_hi(w.w)}; }
__device__ __forceinline__ f32x4 sigm4(f32x4 v) { return (f32x4){sigm(v[0]), sigm(v[1]), sigm(v[2]), sigm(v[3])}; }

template <int MODE> struct Epi1 {
    static constexpr bool PERM = true, AFTER_DRAIN = false;
    bf16_t *O0, *O1; const float* bglu; float qscale;
    __device__ __forceinline__ void operator()(const f32x4 (&acc)[2][2][4][2], const Unit& u, int wr, int wc, int fr, int fq) const {
        const int row0 = u.pm * BM + wr * 64 + fr, cl = wc * 32 + 8 * fq;
        if constexpr (MODE == 0) {
            const float* pa = bglu + 128 * u.pn + cl; const float* pb = pa + 1024;
            const f32x4 ba0 = *(const f32x4*)pa, ba1 = *(const f32x4*)(pa + 4), bb0 = *(const f32x4*)pb, bb1 = *(const f32x4*)(pb + 4);
#pragma unroll
            for (int ai = 0; ai < 2; ++ai)
#pragma unroll
                for (int m = 0; m < 4; ++m) {
                    const f32x4 a0 = acc[ai][0][m][0] + ba0, a1 = acc[ai][0][m][1] + ba1, g0 = acc[ai][1][m][0] + bb0, g1 = acc[ai][1][m][1] + bb1;
                    st8(O0 + (size_t)(row0 + ai * HALF + m * 16) * 1024 + 128 * u.pn + cl, a0 * sigm4(g0), a1 * sigm4(g1)); }
        } else if constexpr (MODE == 1) {
            const bool isq = u.pn < 2; bf16_t* base = isq ? O0 : O1; const int colt = (isq ? u.pn : u.pn - 2) * BM; const float sc = isq ? qscale : 1.0f;
#pragma unroll
            for (int ai = 0; ai < 2; ++ai)
#pragma unroll
                for (int m = 0; m < 4; ++m) { bf16_t* rowp = base + (size_t)(row0 + ai * HALF + m * 16) * 512 + colt + cl;
#pragma unroll
                    for (int bj = 0; bj < 2; ++bj) st8(rowp + bj * HALF, acc[ai][bj][m][0] * sc, acc[ai][bj][m][1] * sc); }
        } else if constexpr (MODE == 2) {
            const int colt = u.pn * BM;
#pragma unroll
            for (int ai = 0; ai < 2; ++ai)
#pragma unroll
                for (int m = 0; m < 4; ++m) { bf16_t* rowp = O0 + (size_t)(row0 + ai * HALF + m * 16) * 1024 + colt + cl;
#pragma unroll
                    for (int bj = 0; bj < 2; ++bj) { const f32x4 v0 = acc[ai][bj][m][0], v1 = acc[ai][bj][m][1]; st8(rowp + bj * HALF, v0 * sigm4(v0), v1 * sigm4(v1)); } }
        } else {
            const int colt = u.pn * BM;
#pragma unroll
            for (int ai = 0; ai < 2; ++ai)
#pragma unroll
                for (int m = 0; m < 4; ++m) { bf16_t* rowp = O0 + (size_t)(row0 + ai * HALF + m * 16) * 2048 + colt + cl;
#pragma unroll
                    for (int bj = 0; bj < 2; ++bj) st8(rowp + bj * HALF, sigm4(acc[ai][bj][m][0]), sigm4(acc[ai][bj][m][1])); }
        }
    }
};
struct EpiVT {
    static constexpr bool PERM = true, AFTER_DRAIN = false;
    bf16_t* VT;
    __device__ __forceinline__ void operator()(const f32x4 (&acc)[2][2][4][2], const Unit& u, int wr, int wc, int fr, int fq) const {
        typedef unsigned u32x2v __attribute__((ext_vector_type(2)));
#pragma unroll
        for (int ai = 0; ai < 2; ++ai)
#pragma unroll
            for (int m = 0; m < 4; ++m) { const int e = ai * HALF + wr * 64 + m * 16 + fr;
#pragma unroll
                for (int bj = 0; bj < 2; ++bj) { const int tok = u.pn * BM + bj * HALF + wc * 32 + 8 * fq; const int b = tok >> 13, chunk = (tok & 8191) >> 6, tk = tok & 63, g0 = tk & 48, x = (tk >> 3) & 1;
                    bf16_t* p = VT + ((size_t)((b * 4 + u.pm) * 128 + chunk) * 256 + e) * 64 + g0 + 4 * x;
                    const f32x4 v0 = acc[ai][bj][m][0], v1 = acc[ai][bj][m][1];
                    *(u32x2v*)p = (u32x2v){pk2(v0[0], v0[1]), pk2(v0[2], v0[3])}; *(u32x2v*)(p + 8) = (u32x2v){pk2(v1[0], v1[1]), pk2(v1[2], v1[3])}; } }
    }
};
__device__ __forceinline__ void unpk8(const u32x4 w, f32x4& v0, f32x4& v1) { v0 = (f32x4){bf_lo(w.x), bf_hi(w.x), bf_lo(w.y), bf_hi(w.y)}; v1 = (f32x4){bf_lo(w.z), bf_hi(w.z), bf_lo(w.w), bf_hi(w.w)}; }
struct EpiConv {
    static constexpr bool PERM = true, AFTER_DRAIN = false;
    bf16_t* GC; const bf16_t* GT; const float* bias;
    __device__ __forceinline__ void operator()(const f32x4 (&acc)[2][2][4][2], const Unit& u, int wr, int wc, int fr, int fq) const {
        const int row0 = u.pm * BM + wr * 64 + fr, col0 = u.pn * BM + wc * 32 + 8 * fq;
        f32x4 bv[2][2];
#pragma unroll
        for (int bj = 0; bj < 2; ++bj)
#pragma unroll
            for (int n = 0; n < 2; ++n) bv[bj][n] = *(const f32x4*)(bias + col0 + bj * HALF + 4 * n);
#pragma unroll
        for (int ai = 0; ai < 2; ++ai) {
            u32x4 graw[4][2];
#pragma unroll
            for (int m = 0; m < 4; ++m)
#pragma unroll
                for (int bj = 0; bj < 2; ++bj) graw[m][bj] = *(const u32x4*)(GT + (size_t)(row0 + ai * HALF + m * 16) * 2048 + col0 + bj * HALF);
#pragma unroll
            for (int m = 0; m < 4; ++m) { const size_t row = (size_t)(row0 + ai * HALF + m * 16);
#pragma unroll
                for (int bj = 0; bj < 2; ++bj) { f32x4 g0, g1; unpk8(graw[m][bj], g0, g1);
                    st8(GC + row * 1024 + col0 + bj * HALF, g0 * (acc[ai][bj][m][0] + bv[bj][0]), g1 * (acc[ai][bj][m][1] + bv[bj][1])); } }
        }
    }
};
struct EpiGla {
    static constexpr bool PERM = true, AFTER_DRAIN = false;
    bf16_t* MG; const bf16_t* GC; const bf16_t* GT;
    __device__ __forceinline__ void operator()(const f32x4 (&acc)[2][2][4][2], const Unit& u, int wr, int wc, int fr, int fq) const {
        const int row0 = u.pm * BM + wr * 64 + fr, col0 = u.pn * BM + wc * 32 + 8 * fq;
#pragma unroll
        for (int ai = 0; ai < 2; ++ai) {
            u32x4 graw[4][2], craw[4][2];
#pragma unroll
            for (int m = 0; m < 4; ++m)
#pragma unroll
                for (int bj = 0; bj < 2; ++bj) { const size_t row = (size_t)(row0 + ai * HALF + m * 16);
                    graw[m][bj] = *(const u32x4*)(GT + row * 2048 + 1024 + col0 + bj * HALF); craw[m][bj] = *(const u32x4*)(GC + row * 1024 + col0 + bj * HALF); }
#pragma unroll
            for (int m = 0; m < 4; ++m) { const size_t row = (size_t)(row0 + ai * HALF + m * 16);
#pragma unroll
                for (int bj = 0; bj < 2; ++bj) { f32x4 g0, g1, c0, c1; unpk8(graw[m][bj], g0, g1); unpk8(craw[m][bj], c0, c1);
                    st8(MG + row * 1024 + col0 + bj * HALF, c0 + g0 * acc[ai][bj][m][0], c1 + g1 * acc[ai][bj][m][1]); } }
        }
    }
};
struct EpiRes {
    static constexpr bool PERM = false, AFTER_DRAIN = false;
    const float* base; float* out; const float* gate;
    __device__ __forceinline__ void operator()(const f32x4 (&acc)[2][2][4][2], const Unit& u, int wr, int wc, int fr, int fq) const {
        const int col0 = u.pn * BM + wc * 32 + 4 * fq; const float* gp = gate + (size_t)((u.pm * BM) >> 13) * 6144 + col0;
        f32x4 gv[2][2];
#pragma unroll
        for (int bj = 0; bj < 2; ++bj)
#pragma unroll
            for (int n = 0; n < 2; ++n) gv[bj][n] = *(const f32x4*)(gp + bj * HALF + n * 16);
#pragma unroll
        for (int ai = 0; ai < 2; ++ai) {
            f32x4 xb[4][2][2];
#pragma unroll
            for (int m = 0; m < 4; ++m) { const size_t off = (size_t)(u.pm * BM + ai * HALF + wr * 64 + m * 16 + fr) * 1024 + col0;
#pragma unroll
                for (int bj = 0; bj < 2; ++bj)
#pragma unroll
                    for (int n = 0; n < 2; ++n) xb[m][bj][n] = *(const f32x4*)(base + off + bj * HALF + n * 16); }
#pragma unroll
            for (int m = 0; m < 4; ++m) { const size_t off = (size_t)(u.pm * BM + ai * HALF + wr * 64 + m * 16 + fr) * 1024 + col0;
#pragma unroll
                for (int bj = 0; bj < 2; ++bj)
#pragma unroll
                    for (int n = 0; n < 2; ++n) *(f32x4*)(out + off + bj * HALF + n * 16) = xb[m][bj][n] + gv[bj][n] * acc[ai][bj][m][n]; }
        }
    }
};
struct EpiFF1 {
    static constexpr bool PERM = true, AFTER_DRAIN = false;
    bf16_t* F1;
    __device__ __forceinline__ void operator()(const f32x4 (&acc)[2][2][4][2], const Unit& u, int wr, int wc, int fr, int fq) const {
        const int row0 = u.pm * BM + wr * 64 + fr, col0 = u.pn * BM + wc * 32 + 8 * fq;
#pragma unroll
        for (int ai = 0; ai < 2; ++ai)
#pragma unroll
            for (int m = 0; m < 4; ++m) { bf16_t* rowp = F1 + (size_t)(row0 + ai * HALF + m * 16) * 4096 + col0;
#pragma unroll
                for (int bj = 0; bj < 2; ++bj) { f32x4 v0 = acc[ai][bj][m][0], v1 = acc[ai][bj][m][1];
                    v0 = __builtin_elementwise_max(v0, (f32x4){0.f, 0.f, 0.f, 0.f}); v1 = __builtin_elementwise_max(v1, (f32x4){0.f, 0.f, 0.f, 0.f});
                    st8(rowp + bj * HALF, v0 * v0, v1 * v1); } }
    }
};
template <class Epi, class Sched, bool ALIGN_EPI = false, bool SP2 = false>
__device__ __forceinline__ void gemm_phase(PG8_LAS unsigned char* lds, const Gemm g, const Sched& S, const Epi& E) {
    const int tid = threadIdx.x, wid = __builtin_amdgcn_readfirstlane(tid >> 6), lane = tid & 63, wr = wid >> 2, wc = wid & 3, fr = lane & 15, fq = lane >> 4;
    const int K = g.K, nt = K / BK;
    unsigned voffA[2], voffB[2];
#pragma unroll
    for (int i = 0; i < 2; ++i) { int R, C; stage_rc(tid * 16 + i * 8192, R, C); const int Rb = Epi::PERM ? ((R & ~31) + perm32(R & 31)) : R;
        voffA[i] = (unsigned)(R * K + C) * 2u; voffB[i] = (unsigned)(Rb * K + C) * 2u; }
    const size_t kstep = (size_t)(BK * 2);
    const size_t hstep = (size_t)HALF * K * 2;
    const size_t tstep = 2 * hstep;
    const unsigned ldsw = (unsigned)wid * 1024u;
    const int aoff = lds_byte(wr * 64 + fr, fq * 8), boff = lds_byte(wc * 32 + fr, fq * 8);
#define PG8_SA(b, h) (((b) * 2 + (h)) * HTB)
#define PG8_SB(b, h) ((4 + (b) * 2 + (h)) * HTB)
#define PG8_STAGE(bufoff, gbase, voff) do { _Pragma("unroll") for (int _i = 0; _i < 2; ++_i) \
        __builtin_amdgcn_global_load_lds((const unsigned*)((const char*)(gbase) + (voff)[_i]), (PG8_LAS unsigned*)(lds + (bufoff) + ldsw + _i * 8192), 16, 0, 0); } while (0)
#define PG8_LDA(dst, b, h) do { _Pragma("unroll") for (int m = 0; m < 4; ++m) _Pragma("unroll") for (int k = 0; k < 2; ++k) dst[m][k] = *(const PG8_LAS bf16x8*)(lds + PG8_SA(b, h) + aoff + m * 2048 + k * 1024); } while (0)
#define PG8_LDB(dst, b, h) do { _Pragma("unroll") for (int n = 0; n < 2; ++n) _Pragma("unroll") for (int k = 0; k < 2; ++k) dst[n][k] = *(const PG8_LAS bf16x8*)(lds + PG8_SB(b, h) + boff + n * 2048 + k * 1024); } while (0)
#define PG8_MMA(ai, bj, At, Bt) do { __builtin_amdgcn_s_setprio(1); _Pragma("unroll") for (int m = 0; m < 4; ++m) _Pragma("unroll") for (int n = 0; n < 2; ++n) _Pragma("unroll") for (int k = 0; k < 2; ++k) \
        acc[ai][bj][m][n] = __builtin_amdgcn_mfma_f32_16x16x32_bf16(Bt[n][k], At[m][k], acc[ai][bj][m][n], 0, 0, 0); __builtin_amdgcn_s_setprio(0); } while (0)
#define PG8_WAIT_V(n) asm volatile("s_waitcnt vmcnt(" #n ")" ::: "memory")
#define PG8_WAIT_L(n) asm volatile("s_waitcnt lgkmcnt(" #n ")" ::: "memory")
#define PG8_BAR __builtin_amdgcn_s_barrier()
#define PG8_SCHED __builtin_amdgcn_sched_barrier(0)
    Unit cur, nxt; int ui = 0;
    if (!S.next(0, cur)) return;
    f32x4 acc[2][2][4][2];
#pragma unroll
    for (int a = 0; a < 2; ++a)
#pragma unroll
        for (int b = 0; b < 2; ++b)
#pragma unroll
            for (int m = 0; m < 4; ++m)
#pragma unroll
                for (int n = 0; n < 2; ++n) acc[a][b][m][n] = (f32x4){0.f, 0.f, 0.f, 0.f};
    bf16x8 At[4][2], B0[2][2], B1[2][2];
    const char* cA = (const char*)g.A + (size_t)cur.pm * tstep; const char* cB = (const char*)g.Bt + (size_t)cur.pn * tstep;
    S.a_ready(cur);
    if constexpr (SP2) {
        PG8_STAGE(PG8_SB(0, 0), cB, voffB); PG8_STAGE(PG8_SB(0, 1), cB + hstep, voffB); PG8_STAGE(PG8_SA(0, 0), cA, voffA); PG8_STAGE(PG8_SA(0, 1), cA + hstep, voffA);
        if (wr == 1) PG8_BAR;
        PG8_WAIT_V(2); PG8_BAR;
        PG8_STAGE(PG8_SB(1, 0), cB + kstep, voffB); PG8_STAGE(PG8_SA(1, 0), cA + kstep, voffA); PG8_STAGE(PG8_SB(1, 1), cB + hstep + kstep, voffB);
        PG8_WAIT_V(6); PG8_BAR;
    } else {
        PG8_STAGE(PG8_SB(0, 0), cB, voffB); PG8_STAGE(PG8_SA(0, 0), cA, voffA); PG8_STAGE(PG8_SB(0, 1), cB + hstep, voffB); PG8_STAGE(PG8_SA(0, 1), cA + hstep, voffA);
        if (wr == 1) PG8_BAR;
        PG8_WAIT_V(4); PG8_BAR;
        PG8_STAGE(PG8_SB(1, 0), cB + kstep, voffB); PG8_STAGE(PG8_SA(1, 0), cA + kstep, voffA); PG8_STAGE(PG8_SB(1, 1), cB + hstep + kstep, voffB);
        PG8_WAIT_V(6); PG8_BAR;
    }
    for (;;) {
        const bool has_next = S.next(ui + 1, nxt);
        const char* nA = has_next ? (const char*)g.A + (size_t)nxt.pm * tstep : cA; const char* nB = has_next ? (const char*)g.Bt + (size_t)nxt.pn * tstep : cB;
        for (int t = 0; t < nt; t += 2) {
            const bool last = (t == nt - 2);
            const char* a1 = cA + (size_t)(t + 1) * kstep;
            const char* a2 = last ? nA : cA + (size_t)(t + 2) * kstep; const char* b2 = last ? nB : cB + (size_t)(t + 2) * kstep;
            const char* a3 = a2 + kstep; const char* b3 = b2 + kstep;
            if (last && has_next) S.a_ready(nxt);
            if constexpr (SP2) {
            PG8_LDB(B0, 0, 0); PG8_LDB(B1, 0, 1); PG8_SCHED; PG8_LDA(At, 0, 0); PG8_STAGE(PG8_SA(1, 1), a1 + hstep, voffA);
            PG8_WAIT_V(8); PG8_WAIT_L(0); PG8_BAR; PG8_MMA(0, 0, At, B0); PG8_MMA(0, 1, At, B1); PG8_BAR; PG8_SCHED;
            PG8_LDA(At, 0, 1); PG8_STAGE(PG8_SB(0, 0), b2, voffB); PG8_STAGE(PG8_SB(0, 1), b2 + hstep, voffB); PG8_STAGE(PG8_SA(0, 0), a2, voffA);
            PG8_WAIT_V(8); PG8_WAIT_L(0); PG8_BAR; PG8_MMA(1, 0, At, B0); PG8_MMA(1, 1, At, B1); PG8_BAR; PG8_SCHED;
            PG8_LDB(B0, 1, 0); PG8_LDB(B1, 1, 1); PG8_SCHED; PG8_LDA(At, 1, 0); PG8_STAGE(PG8_SA(0, 1), a2 + hstep, voffA);
            PG8_WAIT_V(8); PG8_WAIT_L(0); PG8_BAR; PG8_MMA(0, 0, At, B0); PG8_MMA(0, 1, At, B1); PG8_BAR; PG8_SCHED;
            PG8_LDA(At, 1, 1); PG8_STAGE(PG8_SB(1, 0), b3, voffB); PG8_STAGE(PG8_SB(1, 1), b3 + hstep, voffB); PG8_STAGE(PG8_SA(1, 0), a3, voffA);
            PG8_WAIT_V(8); PG8_WAIT_L(0); PG8_BAR; PG8_MMA(1, 0, At, B0); PG8_MMA(1, 1, At, B1); PG8_BAR; PG8_SCHED;
            } else {
            PG8_LDB(B0, 0, 0); PG8_SCHED; PG8_LDA(At, 0, 0); PG8_STAGE(PG8_SA(1, 1), a1 + hstep, voffA);
            PG8_WAIT_L(8); PG8_BAR; PG8_WAIT_L(0); PG8_MMA(0, 0, At, B0); PG8_BAR; PG8_SCHED;
            PG8_LDB(B1, 0, 1); PG8_STAGE(PG8_SB(0, 0), b2, voffB);
            PG8_BAR; PG8_WAIT_L(0); PG8_MMA(0, 1, At, B1); PG8_BAR;
            PG8_LDA(At, 0, 1); PG8_STAGE(PG8_SA(0, 0), a2, voffA);
            PG8_BAR; PG8_WAIT_L(0); PG8_MMA(1, 0, At, B0); PG8_BAR; PG8_SCHED;
            PG8_STAGE(PG8_SB(0, 1), b2 + hstep, voffB);
            PG8_WAIT_V(6); PG8_BAR; PG8_MMA(1, 1, At, B1); PG8_BAR;
            PG8_LDB(B0, 1, 0); PG8_SCHED; PG8_LDA(At, 1, 0); PG8_STAGE(PG8_SA(0, 1), a2 + hstep, voffA);
            PG8_WAIT_L(8); PG8_BAR; PG8_WAIT_L(0); PG8_MMA(0, 0, At, B0); PG8_BAR; PG8_SCHED;
            PG8_LDB(B1, 1, 1); PG8_STAGE(PG8_SB(1, 0), b3, voffB);
            PG8_BAR; PG8_WAIT_L(0); PG8_MMA(0, 1, At, B1); PG8_BAR;
            PG8_LDA(At, 1, 1); PG8_STAGE(PG8_SA(1, 0), a3, voffA);
            PG8_BAR; PG8_WAIT_L(0); PG8_MMA(1, 0, At, B0); PG8_BAR; PG8_SCHED;
            PG8_STAGE(PG8_SB(1, 1), b3 + hstep, voffB);
            PG8_WAIT_V(6); PG8_BAR; PG8_MMA(1, 1, At, B1); PG8_BAR;
            }
        }
        if constexpr (ALIGN_EPI) { if (wr == 0) PG8_BAR; }
        if constexpr (!Epi::AFTER_DRAIN) { E(acc, cur, wr, wc, fr, fq); S.done(cur); }
        if (!has_next) break;
#pragma unroll
        for (int a = 0; a < 2; ++a)
#pragma unroll
            for (int b = 0; b < 2; ++b)
#pragma unroll
                for (int m = 0; m < 4; ++m)
#pragma unroll
                    for (int n = 0; n < 2; ++n) acc[a][b][m][n] = (f32x4){0.f, 0.f, 0.f, 0.f};
        cur = nxt; cA = nA; cB = nB; ++ui;
        if constexpr (ALIGN_EPI) { if (wr == 1) PG8_BAR; }
    }
    PG8_WAIT_V(0);
    if constexpr (!ALIGN_EPI) { if (wr == 0) PG8_BAR; }
    PG8_BAR;
    if constexpr (Epi::AFTER_DRAIN) { E.fused(acc, cur, wr, wc, fr, fq, lds, wid, lane); S.done(cur); }
#undef PG8_SA
#undef PG8_SB
#undef PG8_STAGE
#undef PG8_LDA
#undef PG8_LDB
#undef PG8_MMA
#undef PG8_WAIT_V
#undef PG8_WAIT_L
#undef PG8_BAR
#undef PG8_SCHED
}
}

constexpr int NWAVES = 8;
#ifndef MK_N_LAUNCHES
#define MK_N_LAUNCHES 1
#endif
constexpr int N_LAUNCHES = MK_N_LAUNCHES;
constexpr int N_PHASES = 12;

constexpr int BATCH = 4, SEQ = 8192, D = 1024, M = BATCH * SEQ, FF = 4096, DIN = 7184;
constexpr int NCH = SEQ / 64, NSEG = 16, SEGCH = NCH / NSEG;
constexpr float EPS = 1e-6f;

constexpr size_t MiB = 1u << 20;
constexpr size_t WS_CTL = 0, CTL_ZERO_BYTES = 1 * MiB;
constexpr size_t WS_MOD = 1 * MiB, WS_WLR = 1 * MiB + 128 * 1024;
constexpr size_t WS_W1T = 2 * MiB, WS_WVT = 14 * MiB, WS_WCT = 16 * MiB, WS_WGT = 18 * MiB, WS_WOT = 20 * MiB, WS_WF1T = 22 * MiB, WS_WF2T = 30 * MiB;
constexpr size_t WS_PLR = 38 * MiB;
constexpr size_t WS_U = 40 * MiB;
constexpr size_t WS_Q = 104 * MiB, WS_K = 136 * MiB, WS_VT = 168 * MiB, WS_SG = 232 * MiB, WS_GT = 296 * MiB;
constexpr size_t WS_EST = 424 * MiB, WS_DSEG = 456 * MiB, WS_END = 457 * MiB;
constexpr size_t WS_F1 = 104 * MiB;
constexpr size_t OUT_GC = 64 * MiB;
constexpr int CW_BAR = 4096;

constexpr int RING_OFF = 0, RING_BYTES = 131072;
constexpr int LDSCTL_OFF = 148480, MISC_OFF = LDSCTL_OFF + 320;
constexpr int LDS_BYTES = 149504;

#define GAS __attribute__((address_space(1)))
#define LAS __attribute__((address_space(3)))
#define DI __device__ __forceinline__
typedef unsigned short bf16;
typedef float f32x4 __attribute__((ext_vector_type(4)));
typedef float f32x2 __attribute__((ext_vector_type(2)));
typedef float f32x16 __attribute__((ext_vector_type(16)));
typedef unsigned u32x4 __attribute__((ext_vector_type(4)));
typedef unsigned u32x2 __attribute__((ext_vector_type(2)));
typedef short bf16x8 __attribute__((ext_vector_type(8)));
typedef GAS unsigned gu32;
#define RLX_AGENT __ATOMIC_RELAXED, __HIP_MEMORY_SCOPE_AGENT
using pg8::pk2; using pg8::bf_lo; using pg8::bf_hi; using pg8::sigm;

#define XB_TMO      128
#define XB_XCNT(j)  (256  + 64 * (j))
#define XB_XSUB(j)  (1280 + 64 * (j))
#define XB_XGEN(j)  (2304 + 64 * (j))
#define XB_TOP      3328
#define XB_TOPGEN   3392
#define XCD_BAR_WORDS 3456
#define XB_SPIN_CAP (1u << 18)

__device__ __forceinline__ unsigned xb_ld(unsigned* p)              { return __hip_atomic_load(p, __ATOMIC_RELAXED, __HIP_MEMORY_SCOPE_AGENT); }
__device__ __forceinline__ unsigned xb_add(unsigned* p, unsigned v) { return __hip_atomic_fetch_add(p, v, __ATOMIC_RELAXED, __HIP_MEMORY_SCOPE_AGENT); }
__device__ __forceinline__ unsigned xb_xcc_id() { return (unsigned)__builtin_amdgcn_s_getreg((3 << 11) | 20) & 0xFu; }
#define XB_SPIN(cond, bar) do { unsigned _sp = 0; while (cond) { __builtin_amdgcn_s_sleep(1); \
    if ((++_sp & 255u) == 0u) { if (xb_ld(&(bar)[XB_TMO])) break; if (_sp > XB_SPIN_CAP) { atomicAdd(&(bar)[XB_TMO], 1u); break; } } } } while (0)

struct XcdBarrier {
    unsigned* bar; unsigned x;
    volatile LAS unsigned* st;
};

__device__ __forceinline__ XcdBarrier xcd_barrier_post(unsigned* bar, volatile LAS unsigned* st) {
    XcdBarrier b; b.bar = bar; b.x = xb_xcc_id(); b.st = st;
    if (threadIdx.x == 0) (void)xb_add(&bar[XB_XCNT(b.x)], 1u);
    return b;
}
__device__ __forceinline__ void xcd_barrier_complete(unsigned* bar, unsigned x, unsigned& nloc, unsigned& nx) {
    const unsigned G = gridDim.x * gridDim.y * gridDim.z;
    unsigned sum, cnt, mine, sp = 0u;
    for (;;) {
        sum = 0u; cnt = 0u; mine = 0u;
#pragma unroll
        for (unsigned j = 0; j < 16; ++j) { const unsigned c = xb_ld(&bar[XB_XCNT(j)]); sum += c; cnt += (c > 0u) ? 1u : 0u; mine = (j == x) ? c : mine; }
        if (sum == G) break;
        __builtin_amdgcn_s_sleep(1);
        if ((++sp & 255u) == 0u) { if (xb_ld(&bar[XB_TMO])) break; if (sp > XB_SPIN_CAP) { atomicAdd(&bar[XB_TMO], 1u); break; } }
    }
    nloc = mine > 0u ? mine : 1u; nx = cnt > 0u ? cnt : 1u;
}

__device__ __forceinline__ void xcd_barrier(const XcdBarrier& b) {
    asm volatile("s_waitcnt vmcnt(0)" ::: "memory");
    __syncthreads();
    if (threadIdx.x == 0) {
        unsigned* bar = b.bar;
        __builtin_amdgcn_s_waitcnt(0);
        unsigned nloc = b.st[0], nx = b.st[1];
        if (nloc == 0u) { xcd_barrier_complete(bar, b.x, nloc, nx); b.st[0] = nloc; b.st[1] = nx; }
        const unsigned old = xb_add(&bar[XB_XSUB(b.x)], 1u);
        const unsigned gen = old / nloc;
        if (old + 1u == (gen + 1u) * nloc) {
            __builtin_amdgcn_fence(__ATOMIC_RELEASE, "agent");
            asm volatile("s_waitcnt vmcnt(0)" ::: "memory");
            const unsigned og = xb_add(&bar[XB_TOP], 1u);
            const unsigned tg = og / nx;
            if (og + 1u == (tg + 1u) * nx) xb_add(&bar[XB_TOPGEN], 1u);
            else XB_SPIN(xb_ld(&bar[XB_TOPGEN]) == tg, bar);
            __builtin_amdgcn_fence(__ATOMIC_ACQUIRE, "agent");
            xb_add(&bar[XB_XGEN(b.x)], 1u);
            asm volatile("s_waitcnt vmcnt(0)" ::: "memory");
        } else {
            XB_SPIN(xb_ld(&bar[XB_XGEN(b.x)]) == gen, bar);
            __builtin_amdgcn_fence(__ATOMIC_ACQUIRE, "agent");
            asm volatile("s_waitcnt vmcnt(0)" ::: "memory");
        }
    }
    __syncthreads();
}


DI float wave_sum(float v) {
#pragma unroll
    for (int o = 1; o < 64; o <<= 1) v += __shfl_xor(v, o);
    return v;
}
template <int N, int SZ> DI void bstep(float (&v)[SZ], int lane) {
    const bool up = (lane & N) != 0;
#pragma unroll
    for (int i = 0; i < N; ++i) { const float a = v[i], b = v[i + N]; const float keep = up ? b : a, send = up ? a : b; v[i] = keep + __shfl_xor(send, N); }
}

DI void tr_item(const float* W, int ldw, int K, bf16* WT, int src_c0, int dst_r0, int k0, LAS float* scr, int lane) {
#pragma unroll 8
    for (int i = 0; i < 32; ++i) { const int kk = 2 * i + (lane >> 5); scr[kk * 33 + (lane & 31)] = W[(size_t)(k0 + kk) * ldw + src_c0 + (lane & 31)]; }
    asm volatile("s_waitcnt lgkmcnt(0)" ::: "memory");
    const int c = lane & 7;
#pragma unroll
    for (int j = 0; j < 4; ++j) { const int n = (lane >> 3) + 8 * j; const LAS float* s = scr + (8 * c) * 33 + n;
        u32x4 o; o.x = pk2(s[0 * 33], s[1 * 33]); o.y = pk2(s[2 * 33], s[3 * 33]); o.z = pk2(s[4 * 33], s[5 * 33]); o.w = pk2(s[6 * 33], s[7 * 33]);
        *(u32x4*)(WT + (size_t)(dst_r0 + n) * K + k0 + 8 * c) = o; }
    asm volatile("s_waitcnt lgkmcnt(0)" ::: "memory");
}
DI int g1_src_col(int grp) {
    const int tile = grp >> 3, within = (grp & 7) * 32;
    if (tile < 8) return within < 128 ? 128 * tile + within : 1024 + 128 * tile + (within - 128);
    if (tile < 12) return 32 * grp;
    if (tile < 16) return 4096 + (32 * grp - 3072);
    return 5136 + (32 * grp - 4096);
}
struct P0Args { const float *c, *w_ada, *b_ada, *w_in, *w_conv_out, *w_gla_out, *w_o, *w_ff1, *w_ff2; float* mod; bf16 *W1T, *WVT, *WLR, *WCT, *WGT, *WOT, *WF1T, *WF2T; };
DI void p0_prologue(LAS unsigned char* lds, int vcu, int G, int tid, int lane, int wave, const P0Args& a) {
    if (vcu < 192) {
        LAS float* sc = (LAS float*)lds;
        for (int i = tid; i < 4096; i += 512) { const float v = a.c[i]; sc[i] = v * sigm(v); }
        __syncthreads();
        const int col = tid & 31, kq = tid >> 5, n = 32 * vcu + col;
        float a0 = 0.f, a1 = 0.f, a2 = 0.f, a3 = 0.f;
#pragma unroll 8
        for (int i = 0; i < 64; ++i) { const int k = kq + 16 * i; const float w = a.w_ada[(size_t)k * 6144 + n]; a0 += sc[k] * w; a1 += sc[1024 + k] * w; a2 += sc[2048 + k] * w; a3 += sc[3072 + k] * w; }
        LAS float* red = (LAS float*)(lds + 16384);
        red[(kq * 4 + 0) * 32 + col] = a0; red[(kq * 4 + 1) * 32 + col] = a1; red[(kq * 4 + 2) * 32 + col] = a2; red[(kq * 4 + 3) * 32 + col] = a3;
        __syncthreads();
        if (tid < 128) { const int b = tid >> 5, cc = tid & 31; float s = a.b_ada[32 * vcu + cc];
#pragma unroll
            for (int q = 0; q < 16; ++q) s += red[(q * 4 + b) * 32 + cc];
            a.mod[b * 6144 + 32 * vcu + cc] = s; }
        __syncthreads();
    }
    if (vcu == G - 1) for (int i = tid; i < 16384; i += 512) { const int r = i >> 10, k = i & 1023; a.WLR[i] = (bf16)(pk2(a.w_in[(size_t)k * DIN + 5120 + r], 0.f) & 0xffffu); }
    LAS float* scr = (LAS float*)(lds + wave * 16384);
    const int gw = vcu * NWAVES + wave, NGW = G * NWAVES;
    constexpr int I1 = 192 * 16, IV = 32 * 16, IS = 32 * 16, IF1 = 128 * 16, IF2 = 32 * 64, NITEMS = I1 + IV + 3 * IS + IF1 + IF2;
    for (int it = gw; it < NITEMS; it += NGW) {
        int r = it;
        if (r < I1) { const int kb = r / 192, grp = r % 192; tr_item(a.w_in, DIN, D, a.W1T, g1_src_col(grp), 32 * grp, 64 * kb, scr, lane); continue; } r -= I1;
        if (r < IV) { const int kb = r / 32, grp = r % 32; tr_item(a.w_in, DIN, D, a.WVT, 3072 + 32 * grp, 32 * grp, 64 * kb, scr, lane); continue; } r -= IV;
        if (r < IS) { const int kb = r / 32, grp = r % 32; tr_item(a.w_conv_out, D, D, a.WCT, 32 * grp, 32 * grp, 64 * kb, scr, lane); continue; } r -= IS;
        if (r < IS) { const int kb = r / 32, grp = r % 32; tr_item(a.w_gla_out, D, D, a.WGT, 32 * grp, 32 * grp, 64 * kb, scr, lane); continue; } r -= IS;
        if (r < IS) { const int kb = r / 32, grp = r % 32; tr_item(a.w_o, D, D, a.WOT, 32 * grp, 32 * grp, 64 * kb, scr, lane); continue; } r -= IS;
        if (r < IF1) { const int kb = r / 128, grp = r % 128; tr_item(a.w_ff1, FF, D, a.WF1T, 32 * grp, 32 * grp, 64 * kb, scr, lane); continue; } r -= IF1;
        { const int kb = r / 32, grp = r % 32; tr_item(a.w_ff2, D, FF, a.WF2T, 32 * grp, 32 * grp, 64 * kb, scr, lane); }
    }
}

template <bool WITH_LR>
DI void p_norm(LAS unsigned char* lds, int vcu, int tid, int lane, int wave, const float* src, const float* g, const float* modb, int sc_off, int sh_off, bf16* dst, const bf16* WLR, float* PLR) {
    const int rowbase = vcu * 128; const float* mb = modb + (size_t)(rowbase >> 13) * 6144;
    f32x4 gm[4], sh[4];
#pragma unroll
    for (int j = 0; j < 4; ++j) { const int col = 4 * lane + 256 * j; const f32x4 gv = *(const f32x4*)(g + col), sv = *(const f32x4*)(mb + sc_off + col); gm[j] = gv * (sv + 1.0f); sh[j] = *(const f32x4*)(mb + sh_off + col); }
    for (int sb = 0; sb < 4; ++sb) {
        f32x4 v[4][4];
#pragma unroll
        for (int rr = 0; rr < 4; ++rr)
#pragma unroll
            for (int j = 0; j < 4; ++j) v[rr][j] = *(const f32x4*)(src + (size_t)(rowbase + 32 * sb + 4 * wave + rr) * D + 4 * lane + 256 * j);
#pragma unroll
        for (int rr = 0; rr < 4; ++rr) {
            const int lr = 4 * wave + rr; const size_t row = (size_t)(rowbase + 32 * sb + lr);
            float ss = 0.f;
#pragma unroll
            for (int j = 0; j < 4; ++j) ss += (v[rr][j].x * v[rr][j].x + v[rr][j].y * v[rr][j].y) + (v[rr][j].z * v[rr][j].z + v[rr][j].w * v[rr][j].w);
            const float rstd = rsqrtf(wave_sum(ss) * (1.0f / D) + EPS);
#pragma unroll
            for (int j = 0; j < 4; ++j) { const f32x4 o = v[rr][j] * rstd * gm[j] + sh[j]; u32x2 p; p.x = pk2(o.x, o.y); p.y = pk2(o.z, o.w);
                *(u32x2*)(dst + row * D + 4 * lane + 256 * j) = p;
                if (WITH_LR) *(LAS u32x2*)(lds + lr * 2064 + (4 * lane + 256 * j) * 2) = p; }
        }
        if (WITH_LR) {
            __syncthreads();
            const int rt = wave & 1, kq = wave >> 1, fr = lane & 15, fq = lane >> 4;
            f32x4 acc = (f32x4){0.f, 0.f, 0.f, 0.f};
#pragma unroll
            for (int s = 0; s < 8; ++s) { const int ks = 8 * kq + s;
                const bf16x8 A = *(const LAS bf16x8*)(lds + (16 * rt + fr) * 2064 + (32 * ks + 8 * fq) * 2);
                const bf16x8 B = *(const bf16x8*)(WLR + fr * 1024 + 32 * ks + 8 * fq);
                acc = __builtin_amdgcn_mfma_f32_16x16x32_bf16(A, B, acc, 0, 0, 0); }
            LAS float* red = (LAS float*)(lds + 67584);
#pragma unroll
            for (int i = 0; i < 4; ++i) red[((kq * 2 + rt) * 16 + (4 * fq + i)) * 16 + fr] = acc[i];
            __syncthreads();
            { const int rt2 = tid >> 8, rc = tid & 255; float s = 0.f;
#pragma unroll
              for (int q = 0; q < 4; ++q) s += red[(q * 2 + rt2) * 256 + rc];
              PLR[(size_t)(rowbase + 32 * sb + 16 * rt2 + (rc >> 4)) * 16 + (rc & 15)] = s; }
        }
    }
}
DI void p_final(int vcu, int lane, int wave, float* xio, const float* g) {
    f32x4 gv[4];
#pragma unroll
    for (int j = 0; j < 4; ++j) gv[j] = *(const f32x4*)(g + 4 * lane + 256 * j);
    for (int i0 = 0; i0 < 16; i0 += 4) {
        f32x4 v[4][4];
#pragma unroll
        for (int i = 0; i < 4; ++i)
#pragma unroll
            for (int j = 0; j < 4; ++j) v[i][j] = *(const f32x4*)(xio + (size_t)(vcu * 128 + 16 * wave + i0 + i) * D + 4 * lane + 256 * j);
#pragma unroll
        for (int i = 0; i < 4; ++i) { const size_t row = (size_t)(vcu * 128 + 16 * wave + i0 + i); float ss = 0.f;
#pragma unroll
            for (int j = 0; j < 4; ++j) ss += (v[i][j].x * v[i][j].x + v[i][j].y * v[i][j].y) + (v[i][j].z * v[i][j].z + v[i][j].w * v[i][j].w);
            const float rstd = rsqrtf(wave_sum(ss) * (1.0f / D) + EPS);
#pragma unroll
            for (int j = 0; j < 4; ++j) *(f32x4*)(xio + row * D + 4 * lane + 256 * j) = v[i][j] * rstd * gv[j];
        }
    }
}

template <int J> DI void conv_one(f32x2 (&acc)[32], const f32x2 (&w)[31], const unsigned* up, bool first) {
    unsigned raw = 0u; if (J >= 30 || !first) raw = up[(long)J * 512];
    const f32x2 in = (f32x2){bf_lo(raw), bf_hi(raw)};
#pragma unroll
    for (int k = 0; k < 31; ++k) { const int t = J - k; if (t >= 0 && t < 32) acc[t] += w[k] * in; }
}
template <int... Js> DI void conv_all(std::integer_sequence<int, Js...>, f32x2 (&acc)[32], const f32x2 (&w)[31], const unsigned* up, bool first) { (conv_one<Js>(acc, w, up, first), ...); }
DI void p_conv(LAS unsigned char* lds, int vcu, int tid, int lane, int wave, const bf16* U, const float* w_dw, const float* b_dw, const float* g_cln, const float* b_cln, bf16* UC) {
    const int cp = tid;
    f32x2 w[31];
#pragma unroll
    for (int k = 0; k < 31; ++k) w[k] = *(const f32x2*)(w_dw + k * 1024 + 2 * cp);
    const f32x2 bias = *(const f32x2*)(b_dw + 2 * cp), gl = *(const f32x2*)(g_cln + 2 * cp), bl = *(const f32x2*)(b_cln + 2 * cp);
    LAS float* part = (LAS float*)lds;
    LAS f32x2* stats = (LAS f32x2*)(lds + 2048);
    for (int si = 0; si < 4; ++si) {
        const int r0 = (vcu * 4 + si) * 32; const bool first = (r0 & (SEQ - 1)) == 0;
        f32x2 acc[32];
#pragma unroll
        for (int t = 0; t < 32; ++t) acc[t] = bias;
        const unsigned* up = (const unsigned*)U + ((long)r0 - 30) * 512 + cp;
        conv_all(std::make_integer_sequence<int, 62>{}, acc, w, up, first);
        float v[64];
#pragma unroll
        for (int t = 0; t < 32; ++t) { v[t] = acc[t].x + acc[t].y; v[32 + t] = acc[t].x * acc[t].x + acc[t].y * acc[t].y; }
        bstep<32, 64>(v, lane); bstep<16, 64>(v, lane); bstep<8, 64>(v, lane); bstep<4, 64>(v, lane); bstep<2, 64>(v, lane); bstep<1, 64>(v, lane);
        part[wave * 64 + lane] = v[0];
        __syncthreads();
        if (tid < 32) { float s1 = 0.f, s2 = 0.f;
#pragma unroll
            for (int q = 0; q < 8; ++q) { s1 += part[q * 64 + tid]; s2 += part[q * 64 + 32 + tid]; }
            const float mean = s1 * (1.0f / 1024.0f), var = s2 * (1.0f / 1024.0f) - mean * mean; stats[tid] = (f32x2){mean, rsqrtf(var + EPS)}; }
        __syncthreads();
        unsigned* op = (unsigned*)UC + (size_t)r0 * 512 + cp;
#pragma unroll
        for (int t = 0; t < 32; ++t) { const f32x2 st = stats[t]; float y0 = (acc[t].x - st.x) * st.y * gl.x + bl.x, y1 = (acc[t].y - st.x) * st.y * gl.y + bl.y;
            y0 *= sigm(y0); y1 *= sigm(y1); op[(size_t)t * 512] = pk2(y0, y1); }
    }
}

constexpr int GL_QH = 0, GL_KH = 17408, GL_KT = 34816, GL_OT = 0  , GL_RAWK = 0  ,
              GL_VT = 53248  , GL_PLR = 118784  , GL_TOT = 126976, GL_LA32 = 129024, GL_EREF = 129536, GL_ELAST = 130048,
              GL_PART = 130560, GL_RS = 132608, GL_WA2 = 132864, GL_BA2 = 141056, GL_PF = 141568, GL_END = 147712;
static_assert(GL_END <= LDSCTL_OFF, "GLA LDS map");
typedef short s16x4 __attribute__((ext_vector_type(4)));
DI bf16x8 frag2(const LAS unsigned char* p) {
    const s16x4 lo = *(const LAS s16x4*)p, hi = *(const LAS s16x4*)(p + 16);
    return __builtin_shufflevector(lo, hi, 0, 1, 2, 3, 4, 5, 6, 7);
}
DI bf16x8 frag2p(const LAS unsigned char* p0, const LAS unsigned char* p1) { const s16x4 lo = *(const LAS s16x4*)p0, hi = *(const LAS s16x4*)p1; return __builtin_shufflevector(lo, hi, 0, 1, 2, 3, 4, 5, 6, 7); }
DI bf16x8 pack8(const f32x16& x, int s) {
    u32x4 p; p.x = pk2(x[8 * s], x[8 * s + 1]); p.y = pk2(x[8 * s + 2], x[8 * s + 3]); p.z = pk2(x[8 * s + 4], x[8 * s + 5]); p.w = pk2(x[8 * s + 6], x[8 * s + 7]);
    return __builtin_bit_cast(bf16x8, p);
}
DI float fexp(float x) { return __builtin_amdgcn_exp2f(x * 1.4426950408889634f); }
DI float flog(float x) { return __builtin_amdgcn_logf(x) * 0.6931471805599453f; }
#define MFMA32(a, b, c) __builtin_amdgcn_mfma_f32_32x32x16_bf16((a), (b), (c), 0, 0, 0)
#define BARL() do { asm volatile("s_waitcnt lgkmcnt(0)" ::: "memory"); __builtin_amdgcn_s_barrier(); asm volatile("" ::: "memory"); } while (0)
#define VMW0() asm volatile("s_waitcnt vmcnt(0)" ::: "memory")
struct GlaArgs { const bf16 *Q, *K, *VT, *SG; const float *PLR, *w_a2, *b_a2, *g_gla; float *EST, *DSEG; bf16* O2; };
template <int PASS>
DI void p_gla(LAS unsigned char* lds, int vcu, int tid, int lane, int wave, const GlaArgs& a) {
    const int item = vcu, bh = item >> 4, seg = item & 15, b = bh >> 2, h = bh & 3;
    const int d = tid & 127, tq = tid >> 7, r = lane & 31, hh = lane >> 5, w = wave;
    f32x16 S[4];
    float* est = a.EST + (size_t)item * 32768;
#pragma unroll
    for (int kb = 0; kb < 4; ++kb)
#pragma unroll
        for (int g = 0; g < 4; ++g) { f32x4 v = (f32x4){0.f, 0.f, 0.f, 0.f}; if (PASS == 2) v = *(const f32x4*)(est + (size_t)(((w * 4 + kb) * 4 + g) * 64 + lane) * 4);
            S[kb][4 * g] = v.x; S[kb][4 * g + 1] = v.y; S[kb][4 * g + 2] = v.z; S[kb][4 * g + 3] = v.w; }
    float dsum = 0.f;
    LAS float* BA2 = (LAS float*)(lds + GL_BA2);
    if (tid < 256) {
        const int db = tid >> 6, l = tid & 63; float wv[8];
#pragma unroll
        for (int j = 0; j < 8; ++j) wv[j] = a.w_a2[(8 * (l >> 5) + j) * 512 + h * 128 + 32 * db + (l & 31)];
        u32x4 hi, lo; unsigned hp[4];
#pragma unroll
        for (int j = 0; j < 4; ++j) { hp[j] = pk2(wv[2 * j], wv[2 * j + 1]); }
        hi = (u32x4){hp[0], hp[1], hp[2], hp[3]};
        lo = (u32x4){pk2(wv[0] - bf_lo(hp[0]), wv[1] - bf_hi(hp[0])), pk2(wv[2] - bf_lo(hp[1]), wv[3] - bf_hi(hp[1])), pk2(wv[4] - bf_lo(hp[2]), wv[5] - bf_hi(hp[2])), pk2(wv[6] - bf_lo(hp[3]), wv[7] - bf_hi(hp[3]))};
        *(LAS u32x4*)(lds + GL_WA2 + ((db * 2 + 0) * 64 + l) * 16) = hi; *(LAS u32x4*)(lds + GL_WA2 + ((db * 2 + 1) * 64 + l) * 16) = lo;
    }
    if (tq == 0) BA2[d] = a.b_a2[h * 128 + d];
    LAS float* TOT = (LAS float*)(lds + GL_TOT); LAS float* LA32 = (LAS float*)(lds + GL_LA32); LAS float* EREF = (LAS float*)(lds + GL_EREF); LAS float* ELAST = (LAS float*)(lds + GL_ELAST);
    LAS float* PART = (LAS float*)(lds + GL_PART); LAS float* RS = (LAS float*)(lds + GL_RS);
    const int cb0 = seg * SEGCH; const size_t r00 = (size_t)b * SEQ + (size_t)cb0 * 64;
#define GL_ISSUE_VT(cb_, buf_) do { const bf16* vsrc_ = a.VT + (size_t)(bh * NCH + (cb_)) * 16384; _Pragma("unroll") for (int j_ = 0; j_ < 4; ++j_) { const int B_ = 4 * w + j_, R_ = 8 * B_ + (lane >> 3), c_ = (lane & 7) ^ ((R_ >> 1) & 7); \
        __builtin_amdgcn_global_load_lds((const unsigned*)(vsrc_ + R_ * 64 + c_ * 8), (LAS unsigned*)(lds + GL_VT + (buf_) * 32768 + B_ * 1024), 16, 0, 0); } } while (0)
#define GL_ISSUE_PLR(r0_, buf_) do { _Pragma("unroll") for (int j_ = 0; j_ < 2; ++j_) { const int B_ = 2 * w + j_; \
        __builtin_amdgcn_global_load_lds((const unsigned*)(a.PLR + (r0_) * 16 + B_ * 64 + lane), (LAS unsigned*)(lds + GL_PLR + (buf_) * 4096 + B_ * 256), 4, 0, 0); } } while (0)
#define GL_ISSUE_RAWK(r0_, buf_) do { _Pragma("unroll") for (int j_ = 0; j_ < 2; ++j_) { const int B_ = 2 * w + j_; \
        __builtin_amdgcn_global_load_lds((const unsigned*)(a.K + ((r0_) + 4 * B_ + (lane >> 4)) * 512 + h * 128 + (lane & 15) * 8), (LAS unsigned*)(lds + GL_RAWK + (buf_) * 16384 + B_ * 1024), 16, 0, 0); } } while (0)
    bf16 kraw[16], qraw[16];
    GL_ISSUE_VT(cb0, 0); GL_ISSUE_PLR(r00, 0);
#pragma unroll
    for (int i = 0; i < 16; ++i) { const size_t off = (r00 + 16 * tq + i) * 512 + h * 128 + d; kraw[i] = a.K[off]; qraw[i] = (PASS == 2) ? a.Q[off] : (bf16)0; }
    VMW0(); BARL();
    for (int ci = 0; ci < SEGCH; ++ci) {
        const int cb = cb0 + ci; const size_t r0 = r00 + (size_t)ci * 64; const int vb = ci & 1; const bool more = ci + 1 < SEGCH;
        { const int tb = w & 1, db = w >> 1; const LAS f32x4* ap = (const LAS f32x4*)(lds + GL_PLR + (32 * tb + r) * 64 + 32 * hh);
          const f32x4 p0 = ap[0], p1 = ap[1];
          const unsigned h0 = pk2(p0.x, p0.y), h1 = pk2(p0.z, p0.w), h2 = pk2(p1.x, p1.y), h3 = pk2(p1.z, p1.w);
          const bf16x8 Ah = __builtin_bit_cast(bf16x8, (u32x4){h0, h1, h2, h3});
          const bf16x8 Al = __builtin_bit_cast(bf16x8, (u32x4){pk2(p0.x - bf_lo(h0), p0.y - bf_hi(h0)), pk2(p0.z - bf_lo(h1), p0.w - bf_hi(h1)), pk2(p1.x - bf_lo(h2), p1.y - bf_hi(h2)), pk2(p1.z - bf_lo(h3), p1.w - bf_hi(h3))});
          const bf16x8 Bh = *(const LAS bf16x8*)(lds + GL_WA2 + ((db * 2 + 0) * 64 + lane) * 16), Bl = *(const LAS bf16x8*)(lds + GL_WA2 + ((db * 2 + 1) * 64 + lane) * 16);
          const float bav = BA2[32 * db + r];
          f32x16 Zt;
#pragma unroll
          for (int i = 0; i < 16; ++i) Zt[i] = bav;
          Zt = MFMA32(Ah, Bh, Zt); Zt = MFMA32(Al, Bh, Zt); Zt = MFMA32(Ah, Bl, Zt);
          LAS float* Z = (LAS float*)(lds + GL_VT + (vb ^ 1) * 32768);
#pragma unroll
          for (int i = 0; i < 16; ++i) Z[(32 * tb + (i & 3) + 8 * (i >> 2) + 4 * hh) * 128 + 32 * db + r] = Zt[i]; }
        BARL();
        float bcs[16]; float cs = 0.f;
        { const LAS float* Z = (const LAS float*)(lds + GL_VT + (vb ^ 1) * 32768);
#pragma unroll
          for (int i = 0; i < 16; ++i) { const float z = Z[(16 * tq + i) * 128 + d];
              const float la = (fminf(z, 0.f) - flog(1.0f + fexp(-fabsf(z)))) * (1.0f / 16.0f); cs += la; bcs[i] = cs; } }
        TOT[tq * 128 + d] = cs; if (tq == 2) LA32[d] = bcs[0];
        BARL();
        { const float t0 = TOT[d], t1 = TOT[128 + d], t2 = TOT[256 + d], t3 = TOT[384 + d];
          const float off = (tq > 0 ? t0 : 0.f) + (tq > 1 ? t1 : 0.f) + (tq > 2 ? t2 : 0.f), blast = (t0 + t1) + (t2 + t3), ref = t0 + t1 + LA32[d];
          const float elr = fexp(blast - ref);
          const int dp = (d & ~12) | ((d & 4) << 1) | ((d & 8) >> 1);
          unsigned ktp[8];
#pragma unroll
          for (int i = 0; i < 16; i += 2) {
              const int t = 16 * tq + i;
              const float bt0 = off + bcs[i], bt1 = off + bcs[i + 1]; const float k0 = __uint_as_float((unsigned)kraw[i] << 16), k1 = __uint_as_float((unsigned)kraw[i + 1] << 16);
              const float ek0 = fexp(ref - bt0), ek1 = fexp(ref - bt1);
              ktp[i >> 1] = pk2(k0 * ek0 * elr, k1 * ek1 * elr);
              if (PASS == 2) { const float q0 = __uint_as_float((unsigned)qraw[i] << 16), q1 = __uint_as_float((unsigned)qraw[i + 1] << 16);
                  *(LAS bf16*)(lds + GL_KH + t * 272 + 2 * dp) = (bf16)(pk2(k0 * ek0, 0.f) & 0xffffu); *(LAS bf16*)(lds + GL_KH + (t + 1) * 272 + 2 * dp) = (bf16)(pk2(k1 * ek1, 0.f) & 0xffffu);
                  *(LAS bf16*)(lds + GL_QH + t * 272 + 2 * dp) = (bf16)(pk2(q0 * fexp(bt0 - ref), 0.f) & 0xffffu); *(LAS bf16*)(lds + GL_QH + (t + 1) * 272 + 2 * dp) = (bf16)(pk2(q1 * fexp(bt1 - ref), 0.f) & 0xffffu); }
          }
          *(LAS u32x4*)(lds + GL_KT + d * 144 + 32 * tq) = (u32x4){ktp[0], ktp[1], ktp[4], ktp[5]}; *(LAS u32x4*)(lds + GL_KT + d * 144 + 32 * tq + 16) = (u32x4){ktp[2], ktp[3], ktp[6], ktp[7]};
          if (tq == 0) { ELAST[d] = fexp(blast); if (PASS == 2) EREF[d] = fexp(ref); dsum += blast; } }
        BARL();
        if (more) { GL_ISSUE_VT(cb + 1, vb ^ 1); GL_ISSUE_PLR(r0 + 64, 0);
            if (PASS == 1) {
#pragma unroll
                for (int i = 0; i < 16; ++i) kraw[i] = a.K[(r0 + 64 + 16 * tq + i) * 512 + h * 128 + d];
            } }
        bf16x8 Vf[4];
        { const int R = 32 * w + r, sw = (R >> 1) & 7; const LAS unsigned char* vrow = lds + GL_VT + vb * 32768 + R * 128;
#pragma unroll
          for (int s4 = 0; s4 < 4; ++s4) Vf[s4] = *(const LAS bf16x8*)(vrow + (((2 * s4 + hh) ^ sw) << 4)); }
        f32x16 o0, o1;
        const int cc = tid & 31, rg = tid >> 5;
        u32x4 sgr[4];
        if (PASS == 2) {
#pragma unroll
            for (int i = 0; i < 16; ++i) { o0[i] = 0.f; o1[i] = 0.f; }
            if (w < 3) {
                const int jb = w >> 1, ib = (w + 1) >> 1;
                f32x16 X;
#pragma unroll
                for (int i = 0; i < 16; ++i) X[i] = 0.f;
#pragma unroll
                for (int ks = 0; ks < 8; ++ks) {
                    const bf16x8 Kf = *(const LAS bf16x8*)(lds + GL_KH + (32 * jb + r) * 272 + (16 * ks + 8 * hh) * 2), Qf = *(const LAS bf16x8*)(lds + GL_QH + (32 * ib + r) * 272 + (16 * ks + 8 * hh) * 2);
                    X = MFMA32(Kf, Qf, X);
                }
                if (w != 1) {
#pragma unroll
                    for (int i = 0; i < 16; ++i) { const int j = (i & 3) + 8 * (i >> 2) + 4 * hh; if (j > r) X[i] = 0.f; }
                }
                *(LAS bf16x8*)(lds + GL_PF + ((2 * w) * 64 + lane) * 16) = pack8(X, 0); *(LAS bf16x8*)(lds + GL_PF + ((2 * w + 1) * 64 + lane) * 16) = pack8(X, 1);
            }
            __builtin_amdgcn_sched_barrier(0);
#pragma unroll
            for (int kb = 0; kb < 4; ++kb) {
                f32x16 Ss;
#pragma unroll
                for (int g = 0; g < 4; ++g) { const f32x4 e4 = *(const LAS f32x4*)(EREF + 32 * kb + 8 * g + 4 * hh);
                    Ss[4 * g] = S[kb][4 * g] * e4.x; Ss[4 * g + 1] = S[kb][4 * g + 1] * e4.y; Ss[4 * g + 2] = S[kb][4 * g + 2] * e4.z; Ss[4 * g + 3] = S[kb][4 * g + 3] * e4.w; }
#pragma unroll
                for (int s = 0; s < 2; ++s) { const bf16x8 Sb = pack8(Ss, s); const int ks = 2 * kb + s;
                    const bf16x8 Q0 = *(const LAS bf16x8*)(lds + GL_QH + r * 272 + (16 * ks + 8 * hh) * 2), Q1 = *(const LAS bf16x8*)(lds + GL_QH + (32 + r) * 272 + (16 * ks + 8 * hh) * 2);
                    o0 = MFMA32(Q0, Sb, o0); o1 = MFMA32(Q1, Sb, o1); }
            }
            __builtin_amdgcn_sched_barrier(0);
#pragma unroll
            for (int i = 0; i < 4; ++i) sgr[i] = *(const u32x4*)(a.SG + (r0 + rg + 16 * i) * 1024 + h * 256 + 8 * cc);
            if (more) {
#pragma unroll
                for (int i = 0; i < 16; ++i) { const size_t off = (r0 + 64 + 16 * tq + i) * 512 + h * 128 + d; kraw[i] = a.K[off]; qraw[i] = a.Q[off]; }
            }
            __builtin_amdgcn_sched_barrier(0);
        }
#pragma unroll
        for (int kb = 0; kb < 4; ++kb) {
#pragma unroll
            for (int g = 0; g < 4; ++g) { const f32x4 l4 = *(const LAS f32x4*)(ELAST + 32 * kb + 8 * g + 4 * hh);
                S[kb][4 * g] *= l4.x; S[kb][4 * g + 1] *= l4.y; S[kb][4 * g + 2] *= l4.z; S[kb][4 * g + 3] *= l4.w; }
#pragma unroll
            for (int s4 = 0; s4 < 4; ++s4) { const bf16x8 Af = *(const LAS bf16x8*)(lds + GL_KT + (32 * kb + r) * 144 + (16 * s4 + 8 * hh) * 2); S[kb] = MFMA32(Af, Vf[s4], S[kb]); }
        }
        if (PASS == 2) {
            BARL();
            { bf16x8 P[6];
#pragma unroll
              for (int q = 0; q < 6; ++q) P[q] = *(const LAS bf16x8*)(lds + GL_PF + (q * 64 + lane) * 16);
              o0 = MFMA32(P[0], Vf[0], o0); o0 = MFMA32(P[1], Vf[1], o0);
              o1 = MFMA32(P[2], Vf[0], o1); o1 = MFMA32(P[3], Vf[1], o1); o1 = MFMA32(P[4], Vf[2], o1); o1 = MFMA32(P[5], Vf[3], o1); }
            LAS bf16* OT = (LAS bf16*)(lds + GL_OT);
#pragma unroll
            for (int i = 0; i < 16; ++i) { const int row = (i & 3) + 8 * (i >> 2) + 4 * hh; OT[row * 264 + 32 * w + r] = (bf16)(pk2(o0[i], 0.f) & 0xffffu); OT[(32 + row) * 264 + 32 * w + r] = (bf16)(pk2(o1[i], 0.f) & 0xffffu); }
            VMW0();
            BARL();
            const f32x4 gA = *(const f32x4*)(a.g_gla + h * 256 + 8 * cc), gB = *(const f32x4*)(a.g_gla + h * 256 + 8 * cc + 4);
#pragma unroll
            for (int i = 0; i < 4; ++i) { const int row = rg + 16 * i;
                f32x4 oa, ob; pg8::unpk8(*(const LAS u32x4*)(OT + row * 264 + 8 * cc), oa, ob);
                float ss = (oa.x * oa.x + oa.y * oa.y) + (oa.z * oa.z + oa.w * oa.w) + (ob.x * ob.x + ob.y * ob.y) + (ob.z * ob.z + ob.w * ob.w);
                ss += __shfl_xor(ss, 1); ss += __shfl_xor(ss, 2); ss += __shfl_xor(ss, 4); ss += __shfl_xor(ss, 8); ss += __shfl_xor(ss, 16);
                const float rs = rsqrtf(ss * (1.0f / 256.0f) + EPS);
                f32x4 s0, s1; pg8::unpk8(sgr[i], s0, s1);
                pg8::st8(a.O2 + (r0 + row) * 1024 + h * 256 + 8 * cc, oa * rs * gA * s0, ob * rs * gB * s1); }
        } else {
            VMW0(); BARL();
        }
    }
    if (PASS == 1) {
#pragma unroll
        for (int kb = 0; kb < 4; ++kb)
#pragma unroll
            for (int g = 0; g < 4; ++g) *(f32x4*)(est + (size_t)(((w * 4 + kb) * 4 + g) * 64 + lane) * 4) = (f32x4){S[kb][4 * g], S[kb][4 * g + 1], S[kb][4 * g + 2], S[kb][4 * g + 3]};
        if (tq == 0) a.DSEG[item * 128 + d] = __expf(dsum);
    }
    asm volatile("s_waitcnt vmcnt(0) lgkmcnt(0)" ::: "memory"); __syncthreads();
#undef GL_ISSUE_VT
#undef GL_ISSUE_PLR
#undef GL_ISSUE_RAWK
}
DI void p_prefix(int vcu, int tid, float* EST, const float* DSEG) {
    const int gid = vcu * 512 + tid, bh = gid >> 13, qi = gid & 8191, lane_ = qi & 63, g = (qi >> 6) & 3, kb = (qi >> 8) & 3, dk0 = 32 * kb + 8 * g + 4 * (lane_ >> 5);
    f32x4 E[NSEG], Dv[NSEG];
#pragma unroll
    for (int s = 0; s < NSEG; ++s) { E[s] = *(const f32x4*)(EST + ((size_t)(bh * NSEG + s) * 8192 + qi) * 4); Dv[s] = *(const f32x4*)(DSEG + (bh * NSEG + s) * 128 + dk0); }
    f32x4 run = (f32x4){0.f, 0.f, 0.f, 0.f};
#pragma unroll
    for (int s = 0; s < NSEG; ++s) { *(f32x4*)(EST + ((size_t)(bh * NSEG + s) * 8192 + qi) * 4) = run; run = Dv[s] * run + E[s]; }
}

struct Args { const float* in[22]; float* out; unsigned char* ws; int ph_lo, ph_hi, li, pad; };
__global__ void __launch_bounds__(NWAVES * 64, 2) hyb_fwd(Args args) {
    extern __shared__ __attribute__((aligned(16))) unsigned char lds_raw[];
    LAS unsigned char* lds = (LAS unsigned char*)lds_raw;
    volatile LAS unsigned* MISC = (volatile LAS unsigned*)(lds + MISC_OFF);
    const int tid = threadIdx.x, lane = tid & 63, wave = __builtin_amdgcn_readfirstlane(tid >> 6);
    const int G = gridDim.x; const int bx = blockIdx.x; const int vcu = (G % 8 == 0) ? (bx % 8) * (G / 8) + bx / 8 : bx;
    unsigned char* ws = args.ws;
    gu32* ctl = (gu32*)(ws + WS_CTL);
    for (int u = tid; u < (LDS_BYTES - LDSCTL_OFF) / 4; u += NWAVES * 64) ((LAS unsigned*)(lds + LDSCTL_OFF))[u] = 0u;
    __syncthreads();
    XcdBarrier bar; bar.bar = (unsigned*)(ctl + CW_BAR); bar.x = 0; bar.st = nullptr;
    if (N_LAUNCHES == 1) bar = xcd_barrier_post((unsigned*)(ctl + CW_BAR), MISC + 8);
#define GRID_BAR() do { if (N_LAUNCHES == 1) xcd_barrier(bar); } while (0)
    const int lo = args.ph_lo, hi = args.ph_hi;
#ifndef PH_MASK
#define PH_MASK 0xFFF
#endif
#define IN(k) (((PH_MASK >> (k)) & 1) && lo <= (k) && (k) < hi)
#define BOTH(k) (IN(k) && IN((k) + 1))
    const float* x = args.in[0];
    float* mod = (float*)(ws + WS_MOD);
    bf16* WLR = (bf16*)(ws + WS_WLR); bf16* W1T = (bf16*)(ws + WS_W1T); bf16* WVT = (bf16*)(ws + WS_WVT); bf16* WCT = (bf16*)(ws + WS_WCT); bf16* WGT = (bf16*)(ws + WS_WGT);
    bf16* WOT = (bf16*)(ws + WS_WOT); bf16* WF1T = (bf16*)(ws + WS_WF1T); bf16* WF2T = (bf16*)(ws + WS_WF2T);
    float* PLR = (float*)(ws + WS_PLR);
    bf16* Ub = (bf16*)(ws + WS_U); bf16* MG = Ub; bf16* H2 = Ub;
    bf16* Qb = (bf16*)(ws + WS_Q); bf16* Kb = (bf16*)(ws + WS_K); bf16* VTb = (bf16*)(ws + WS_VT); bf16* SGb = (bf16*)(ws + WS_SG); bf16* GTb = (bf16*)(ws + WS_GT);
    float* EST = (float*)(ws + WS_EST); float* DSEG = (float*)(ws + WS_DSEG);
    bf16* F1 = (bf16*)(ws + WS_F1);
    bf16* Hb = (bf16*)args.out; bf16* UC = Hb; bf16* O2 = Hb; bf16* GC = (bf16*)((unsigned char*)args.out + OUT_GC);
    float* X1 = args.out;

    if (IN(0)) {
        P0Args a{args.in[1], args.in[2], args.in[3], args.in[5], args.in[11], args.in[16], args.in[17], args.in[19], args.in[20], mod, W1T, WVT, WLR, WCT, WGT, WOT, WF1T, WF2T};
        p0_prologue(lds, vcu, G, tid, lane, wave, a);
        if (BOTH(0)) GRID_BAR();
    }
    if (IN(1)) {
        p_norm<true>(lds, vcu, tid, lane, wave, x, args.in[4], mod, 1024, 0, Hb, WLR, PLR);
        if (BOTH(1)) GRID_BAR();
    }
    if (IN(2)) {
        const float qs = 0.08838834764831845f;
        { pg8::Gemm g{Hb, W1T, M, 2048, D}; pg8::StaticOrder S; S.init(M, 2048, G, bx);
          pg8::Epi1<0> E{Ub, nullptr, args.in[6], qs};
          pg8::gemm_phase<pg8::Epi1<0>, pg8::StaticOrder, true, true>(lds + RING_OFF, g, S, E); }
        { pg8::Gemm g{Hb, W1T + (size_t)2048 * D, M, 1024, D}; pg8::StaticOrder S; S.init(M, 1024, G, bx);
          pg8::Epi1<1> E{Qb, Kb, nullptr, qs};
          pg8::gemm_phase<pg8::Epi1<1>, pg8::StaticOrder, true, true>(lds + RING_OFF, g, S, E); }
        { pg8::Gemm g{Hb, W1T + (size_t)3072 * D, M, 1024, D}; pg8::StaticOrder S; S.init(M, 1024, G, bx);
          pg8::Epi1<2> E{SGb, nullptr, nullptr, qs};
          pg8::gemm_phase<pg8::Epi1<2>, pg8::StaticOrder, true, true>(lds + RING_OFF, g, S, E); }
        { pg8::Gemm g{Hb, W1T + (size_t)4096 * D, M, 2048, D}; pg8::StaticOrder S; S.init(M, 2048, G, bx);
          pg8::Epi1<3> E{GTb, nullptr, nullptr, qs};
          pg8::gemm_phase<pg8::Epi1<3>, pg8::StaticOrder, true, true>(lds + RING_OFF, g, S, E); }
        { pg8::Gemm g{WVT, Hb, D, M, D}; pg8::StaticOrder S; S.init(D, M, G, bx);
          pg8::EpiVT E{VTb};
          pg8::gemm_phase<pg8::EpiVT, pg8::StaticOrder, true, true>(lds + RING_OFF, g, S, E); }
        if (BOTH(2)) GRID_BAR();
    }
    if (IN(3)) {
        p_conv(lds, vcu, tid, lane, wave, Ub, args.in[7], args.in[8], args.in[9], args.in[10], UC);
        __syncthreads();
        GlaArgs a{Qb, Kb, VTb, SGb, PLR, args.in[13], args.in[14], args.in[15], EST, DSEG, O2};
        p_gla<1>(lds, vcu, tid, lane, wave, a);
        if (BOTH(3)) GRID_BAR();
    }
    if (IN(4)) {
        p_prefix(vcu, tid, EST, DSEG);
        { pg8::Gemm g{UC, WCT, M, D, D}; pg8::StaticOrder S; S.init(M, D, G, bx);
          pg8::EpiConv E{GC, GTb, args.in[12]};
          pg8::gemm_phase<pg8::EpiConv, pg8::StaticOrder, true, true>(lds + RING_OFF, g, S, E); }
        if (BOTH(4)) GRID_BAR();
    }
    if (IN(5)) {
        GlaArgs a{Qb, Kb, VTb, SGb, PLR, args.in[13], args.in[14], args.in[15], EST, DSEG, O2};
        p_gla<2>(lds, vcu, tid, lane, wave, a);
        if (BOTH(5)) GRID_BAR();
    }
    if (IN(6)) {
        { pg8::Gemm g{O2, WGT, M, D, D}; pg8::StaticOrder S; S.init(M, D, G, bx);
          pg8::EpiGla E{MG, GC, GTb};
          pg8::gemm_phase<pg8::EpiGla, pg8::StaticOrder, true, true>(lds + RING_OFF, g, S, E); }
        if (BOTH(6)) GRID_BAR();
    }
    if (IN(7)) {
        { pg8::Gemm g{MG, WOT, M, D, D}; pg8::StaticOrder S; S.init(M, D, G, bx);
          pg8::EpiRes E{x, X1, mod + 2048};
          pg8::gemm_phase<pg8::EpiRes, pg8::StaticOrder, true, true>(lds + RING_OFF, g, S, E); }
        if (BOTH(7)) GRID_BAR();
    }
    if (IN(8)) {
        p_norm<false>(lds, vcu, tid, lane, wave, X1, args.in[18], mod, 4096, 3072, H2, nullptr, nullptr);
        if (BOTH(8)) GRID_BAR();
    }
    if (IN(9)) {
        { pg8::Gemm g{H2, WF1T, M, FF, D}; pg8::StaticOrder S; S.init(M, FF, G, bx);
          pg8::EpiFF1 E{F1};
          pg8::gemm_phase<pg8::EpiFF1, pg8::StaticOrder, true, true>(lds + RING_OFF, g, S, E); }
        if (BOTH(9)) GRID_BAR();
    }
    if (IN(10)) {
        { pg8::Gemm g{F1, WF2T, M, D, FF}; pg8::StaticOrder S; S.init(M, D, G, bx);
          pg8::EpiRes E{X1, X1, mod + 5120};
          pg8::gemm_phase<pg8::EpiRes, pg8::StaticOrder, true, true>(lds + RING_OFF, g, S, E); }
        if (BOTH(10)) GRID_BAR();
    }
    if (IN(11)) p_final(vcu, lane, wave, X1, args.in[21]);
#undef IN
#undef BOTH
}

extern "C" void kernel_launch(void* const* d_in, const int* in_sizes, int n_in, void* d_out, int out_size, void* d_ws, size_t ws_size, hipStream_t stream) {
    static int grid = 0;
    if (grid == 0) {
        if (n_in != 22 || in_sizes[0] != M * D || out_size != M * D || ws_size < WS_END) { fprintf(stderr, "kernel_launch: shape/workspace mismatch: n_in %d in0 %d out %d ws %zu (need %zu)\n", n_in, n_in > 0 ? in_sizes[0] : -1, out_size, ws_size, (size_t)WS_END); grid = -1; return; }
        int dev = 0, cus = 0, per_cu = 0;
        if (hipGetDevice(&dev) != hipSuccess || hipDeviceGetAttribute(&cus, hipDeviceAttributeMultiprocessorCount, dev) != hipSuccess) { grid = -1; return; }
        if (hipFuncSetAttribute((const void*)hyb_fwd, hipFuncAttributeMaxDynamicSharedMemorySize, LDS_BYTES) != hipSuccess) { fprintf(stderr, "kernel_launch: hipFuncSetAttribute failed\n"); grid = -1; return; }
        if (hipOccupancyMaxActiveBlocksPerMultiprocessor(&per_cu, (const void*)hyb_fwd, NWAVES * 64, LDS_BYTES) != hipSuccess || per_cu < 1) { fprintf(stderr, "kernel_launch: occupancy query says %d blocks per CU\n", per_cu); (void)hipGetLastError(); grid = -1; return; }
        grid = cus;
        if (grid != 256) fprintf(stderr, "kernel_launch: note: %d CUs; the phase program is balanced for 256\n", grid);
    }
    if (grid < 0) return;
    (void)hipMemsetAsync((char*)d_ws + WS_CTL, 0, CTL_ZERO_BYTES, stream);
    Args a{};
    for (int i = 0; i < 22; ++i) a.in[i] = (const float*)d_in[i];
    a.out = (float*)d_out; a.ws = (unsigned char*)d_ws;
#ifdef PROBE_PRE
    {
        a.ph_lo = 0; a.ph_hi = PROBE_PRE; a.li = 0;
        void* kargs0[] = {&a};
        (void)hipLaunchCooperativeKernel((const void*)hyb_fwd, dim3(grid), dim3(NWAVES * 64), kargs0, LDS_BYTES, stream);
        (void)hipMemsetAsync((char*)d_ws + WS_CTL, 0, CTL_ZERO_BYTES, stream);
    }
#endif
    if (N_LAUNCHES == 1) {
        a.ph_lo = 0; a.ph_hi = N_PHASES; a.li = 0;
        void* kargs[] = {&a};
        hipError_t e = hipLaunchCooperativeKernel((const void*)hyb_fwd, dim3(grid), dim3(NWAVES * 64), kargs, LDS_BYTES, stream);
        if (e != hipSuccess) fprintf(stderr, "kernel_launch: cooperative launch failed: %s (grid %d)\n", hipGetErrorString(e), grid);
    } else {
        for (int li = 0; li < N_PHASES; ++li) { a.ph_lo = li; a.ph_hi = li + 1; a.li = li; hipLaunchKernelGGL(hyb_fwd, dim3(grid), dim3(NWAVES * 64), LDS_BYTES, stream, a); }
    }
}
```

```cpp
#include <hip/hip_runtime.h>
#include <cstdio>
#include <cstdint>
#include <utility>
namespace pg8 {
#define PG8_LAS __attribute__((address_space(3)))
typedef unsigned short bf16_t;
typedef short bf16x8 __attribute__((ext_vector_type(8)));
typedef float f32x4 __attribute__((ext_vector_type(4)));
typedef unsigned u32x4 __attribute__((ext_vector_type(4)));
constexpr int BM = 256, BK = 64, HALF = 128, HTB = HALF * BK * 2  , STAGE_BYTES = 8 * HTB, NXCD = 8, WGM = 8;

__host__ __device__ __forceinline__ int lds_byte(int r, int c) { const int st = (r >> 4) * 2 + (c >> 5), rr = r & 15, cc = c & 31, ob = rr * 64 + cc * 2; return st * 1024 + (ob ^ (((ob >> 9) & 1) << 5)); }
__host__ __device__ __forceinline__ void stage_rc(int b, int& R, int& C) { const int st = b / 1024, sb = b % 1024, swz = sb ^ (((sb >> 9) & 1) << 5); R = (st >> 1) * 16 + swz / 64; C = (st & 1) * 32 + (swz % 64) / 2; }
__host__ __device__ __forceinline__ int perm32(int rho) { const int n = rho >> 4, i = rho & 15; return 8 * (i >> 2) + 4 * n + (i & 3); }

struct Unit { int pm, pn; };
struct Gemm { const bf16_t* A; const bf16_t* Bt; int M, N, K; };

struct StaticOrder {
    int nM, nN, nwg, G, c;
    __host__ __device__ void init(int M, int N, int G_, int c_) { nM = M / BM; nN = N / BM; nwg = nM * nN; G = G_; c = c_; }
    __host__ __device__ bool next(int i, Unit& u) const {
        const long L = (long)i * G + c; if (L >= nwg) return false;
        int wgid = (int)L; { const int q = nwg / NXCD, r = nwg % NXCD, xcd = wgid % NXCD, off = wgid / NXCD; wgid = (xcd < r ? xcd * (q + 1) : r * (q + 1) + (xcd - r) * q) + off; }
        const int nig = WGM * nN, gid = wgid / nig, fm = gid * WGM, gsz = (nM - fm) < WGM ? (nM - fm) : WGM;
        u.pm = fm + ((wgid % nig) % gsz); u.pn = (wgid % nig) / gsz; return true;
    }
    __device__ __forceinline__ void a_ready(const Unit&) const {}
    __device__ __forceinline__ void done(const Unit&) const {}
};


typedef float f32x2 __attribute__((ext_vector_type(2)));
typedef __bf16 bf16x2_t __attribute__((ext_vector_type(2)));
__device__ __forceinline__ unsigned pk2(float lo, float hi) { f32x2 v = {lo, hi}; return __builtin_bit_cast(unsigned, __builtin_convertvector(v, bf16x2_t)); }
__device__ __forceinline__ float bf_lo(unsigned u) { return __uint_as_float(u << 16); }
__device__ __forceinline__ float bf_hi(unsigned u) { return __uint_as_float(u & 0xffff0000u); }
__device__ __forceinline__ float sigm(float x) { return __builtin_amdgcn_rcpf(1.0f + __expf(-x)); }
__device__ __forceinline__ void st8(bf16_t* p, f32x4 v0, f32x4 v1) { u32x4 w; w.x = pk2(v0[0], v0[1]); w.y = pk2(v0[2], v0[3]); w.z = pk2(v1[0], v1[1]); w.w = pk2(v1[2], v1[3]); *(u32x4*)p = w; }
__device__ __forceinline__ void ld8(const bf16_t* p, f32x4& v0, f32x4& v1) { const u32x4 w = *(const u32x4*)p; v0 = (f32x4){bf_lo(w.x), bf_hi(w.x), bf_lo(w.y), bf_hi(w.y)}; v1 = (f32x4){bf_lo(w.z), bf_hi(w.z), bf_lo(w.w), bf_hi(w.w)}; }
__device__ __forceinline__ f32x4 sigm4(f32x4 v) { return (f32x4){sigm(v[0]), sigm(v[1]), sigm(v[2]), sigm(v[3])}; }

template <int MODE> struct Epi1 {
    static constexpr bool PERM = true, AFTER_DRAIN = false;
    bf16_t *O0, *O1; const float* bglu; float qscale;
    __device__ __forceinline__ void operator()(const f32x4 (&acc)[2][2][4][2], const Unit& u, int wr, int wc, int fr, int fq) const {
        const int row0 = u.pm * BM + wr * 64 + fr, cl = wc * 32 + 8 * fq;
        if constexpr (MODE == 0) {
            const float* pa = bglu + 128 * u.pn + cl; const float* pb = pa + 1024;
            const f32x4 ba0 = *(const f32x4*)pa, ba1 = *(const f32x4*)(pa + 4), bb0 = *(const f32x4*)pb, bb1 = *(const f32x4*)(pb + 4);
#pragma unroll
            for (int ai = 0; ai < 2; ++ai)
#pragma unroll
                for (int m = 0; m < 4; ++m) {
                    const f32x4 a0 = acc[ai][0][m][0] + ba0, a1 = acc[ai][0][m][1] + ba1, g0 = acc[ai][1][m][0] + bb0, g1 = acc[ai][1][m][1] + bb1;
                    st8(O0 + (size_t)(row0 + ai * HALF + m * 16) * 1024 + 128 * u.pn + cl, a0 * sigm4(g0), a1 * sigm4(g1)); }
        } else if constexpr (MODE == 1) {
            const bool isq = u.pn < 2; bf16_t* base = isq ? O0 : O1; const int colt = (isq ? u.pn : u.pn - 2) * BM; const float sc = isq ? qscale : 1.0f;
#pragma unroll
            for (int ai = 0; ai < 2; ++ai)
#pragma unroll
                for (int m = 0; m < 4; ++m) { bf16_t* rowp = base + (size_t)(row0 + ai * HALF + m * 16) * 512 + colt + cl;
#pragma unroll
                    for (int bj = 0; bj < 2; ++bj) st8(rowp + bj * HALF, acc[ai][bj][m][0] * sc, acc[ai][bj][m][1] * sc); }
        } else if constexpr (MODE == 2) {
            const int colt = u.pn * BM;
#pragma unroll
            for (int ai = 0; ai < 2; ++ai)
#pragma unroll
                for (int m = 0; m < 4; ++m) { bf16_t* rowp = O0 + (size_t)(row0 + ai * HALF + m * 16) * 1024 + colt + cl;
#pragma unroll
                    for (int bj = 0; bj < 2; ++bj) { const f32x4 v0 = acc[ai][bj][m][0], v1 = acc[ai][bj][m][1]; st8(rowp + bj * HALF, v0 * sigm4(v0), v1 * sigm4(v1)); } }
        } else {
            const int colt = u.pn * BM;
#pragma unroll
            for (int ai = 0; ai < 2; ++ai)
#pragma unroll
                for (int m = 0; m < 4; ++m) { bf16_t* rowp = O0 + (size_t)(row0 + ai * HALF + m * 16) * 2048 + colt + cl;
#pragma unroll
                    for (int bj = 0; bj < 2; ++bj) st8(rowp + bj * HALF, sigm4(acc[ai][bj][m][0]), sigm4(acc[ai][bj][m][1])); }
        }
    }
};
struct EpiVT {
    static constexpr bool PERM = true, AFTER_DRAIN = false;
    bf16_t* VT;
    __device__ __forceinline__ void operator()(const f32x4 (&acc)[2][2][4][2], const Unit& u, int wr, int wc, int fr, int fq) const {
#pragma unroll
        for (int ai = 0; ai < 2; ++ai)
#pragma unroll
            for (int m = 0; m < 4; ++m) { const int e = ai * HALF + wr * 64 + m * 16 + fr;
#pragma unroll
                for (int bj = 0; bj < 2; ++bj) { const int tok = u.pn * BM + bj * HALF + wc * 32 + 8 * fq; const int b = tok >> 13, chunk = (tok & 8191) >> 6, tk = tok & 63;
                    st8(VT + ((size_t)((b * 4 + u.pm) * 128 + chunk) * 256 + e) * 64 + tk, acc[ai][bj][m][0], acc[ai][bj][m][1]); } }
    }
};
__device__ __forceinline__ void unpk8(const u32x4 w, f32x4& v0, f32x4& v1) { v0 = (f32x4){bf_lo(w.x), bf_hi(w.x), bf_lo(w.y), bf_hi(w.y)}; v1 = (f32x4){bf_lo(w.z), bf_hi(w.z), bf_lo(w.w), bf_hi(w.w)}; }
struct EpiConv {
    static constexpr bool PERM = true, AFTER_DRAIN = false;
    bf16_t* GC; const bf16_t* GT; const float* bias;
    __device__ __forceinline__ void operator()(const f32x4 (&acc)[2][2][4][2], const Unit& u, int wr, int wc, int fr, int fq) const {
        const int row0 = u.pm * BM + wr * 64 + fr, col0 = u.pn * BM + wc * 32 + 8 * fq;
        f32x4 bv[2][2];
#pragma unroll
        for (int bj = 0; bj < 2; ++bj)
#pragma unroll
            for (int n = 0; n < 2; ++n) bv[bj][n] = *(const f32x4*)(bias + col0 + bj * HALF + 4 * n);
#pragma unroll
        for (int ai = 0; ai < 2; ++ai) {
            u32x4 graw[4][2];
#pragma unroll
            for (int m = 0; m < 4; ++m)
#pragma unroll
                for (int bj = 0; bj < 2; ++bj) graw[m][bj] = *(const u32x4*)(GT + (size_t)(row0 + ai * HALF + m * 16) * 2048 + col0 + bj * HALF);
#pragma unroll
            for (int m = 0; m < 4; ++m) { const size_t row = (size_t)(row0 + ai * HALF + m * 16);
#pragma unroll
                for (int bj = 0; bj < 2; ++bj) { f32x4 g0, g1; unpk8(graw[m][bj], g0, g1);
                    st8(GC + row * 1024 + col0 + bj * HALF, g0 * (acc[ai][bj][m][0] + bv[bj][0]), g1 * (acc[ai][bj][m][1] + bv[bj][1])); } }
        }
    }
};
struct EpiGla {
    static constexpr bool PERM = true, AFTER_DRAIN = false;
    bf16_t* MG; const bf16_t* GC; const bf16_t* GT;
    __device__ __forceinline__ void operator()(const f32x4 (&acc)[2][2][4][2], const Unit& u, int wr, int wc, int fr, int fq) const {
        const int row0 = u.pm * BM + wr * 64 + fr, col0 = u.pn * BM + wc * 32 + 8 * fq;
#pragma unroll
        for (int ai = 0; ai < 2; ++ai) {
            u32x4 graw[4][2], craw[4][2];
#pragma unroll
            for (int m = 0; m < 4; ++m)
#pragma unroll
                for (int bj = 0; bj < 2; ++bj) { const size_t row = (size_t)(row0 + ai * HALF + m * 16);
                    graw[m][bj] = *(const u32x4*)(GT + row * 2048 + 1024 + col0 + bj * HALF); craw[m][bj] = *(const u32x4*)(GC + row * 1024 + col0 + bj * HALF); }
#pragma unroll
            for (int m = 0; m < 4; ++m) { const size_t row = (size_t)(row0 + ai * HALF + m * 16);
#pragma unroll
                for (int bj = 0; bj < 2; ++bj) { f32x4 g0, g1, c0, c1; unpk8(graw[m][bj], g0, g1); unpk8(craw[m][bj], c0, c1);
                    st8(MG + row * 1024 + col0 + bj * HALF, c0 + g0 * acc[ai][bj][m][0], c1 + g1 * acc[ai][bj][m][1]); } }
        }
    }
};
struct EpiRes {
    static constexpr bool PERM = false, AFTER_DRAIN = false;
    const float* base; float* out; const float* gate;
    __device__ __forceinline__ void operator()(const f32x4 (&acc)[2][2][4][2], const Unit& u, int wr, int wc, int fr, int fq) const {
        const int col0 = u.pn * BM + wc * 32 + 4 * fq; const float* gp = gate + (size_t)((u.pm * BM) >> 13) * 6144 + col0;
        f32x4 gv[2][2];
#pragma unroll
        for (int bj = 0; bj < 2; ++bj)
#pragma unroll
            for (int n = 0; n < 2; ++n) gv[bj][n] = *(const f32x4*)(gp + bj * HALF + n * 16);
#pragma unroll
        for (int ai = 0; ai < 2; ++ai) {
            f32x4 xb[4][2][2];
#pragma unroll
            for (int m = 0; m < 4; ++m) { const size_t off = (size_t)(u.pm * BM + ai * HALF + wr * 64 + m * 16 + fr) * 1024 + col0;
#pragma unroll
                for (int bj = 0; bj < 2; ++bj)
#pragma unroll
                    for (int n = 0; n < 2; ++n) xb[m][bj][n] = *(const f32x4*)(base + off + bj * HALF + n * 16); }
#pragma unroll
            for (int m = 0; m < 4; ++m) { const size_t off = (size_t)(u.pm * BM + ai * HALF + wr * 64 + m * 16 + fr) * 1024 + col0;
#pragma unroll
                for (int bj = 0; bj < 2; ++bj)
#pragma unroll
                    for (int n = 0; n < 2; ++n) *(f32x4*)(out + off + bj * HALF + n * 16) = xb[m][bj][n] + gv[bj][n] * acc[ai][bj][m][n]; }
        }
    }
};
struct EpiFF1 {
    static constexpr bool PERM = true, AFTER_DRAIN = false;
    bf16_t* F1;
    __device__ __forceinline__ void operator()(const f32x4 (&acc)[2][2][4][2], const Unit& u, int wr, int wc, int fr, int fq) const {
        const int row0 = u.pm * BM + wr * 64 + fr, col0 = u.pn * BM + wc * 32 + 8 * fq;
#pragma unroll
        for (int ai = 0; ai < 2; ++ai)
#pragma unroll
            for (int m = 0; m < 4; ++m) { bf16_t* rowp = F1 + (size_t)(row0 + ai * HALF + m * 16) * 4096 + col0;
#pragma unroll
                for (int bj = 0; bj < 2; ++bj) { f32x4 v0 = acc[ai][bj][m][0], v1 = acc[ai][bj][m][1];
                    v0 = __builtin_elementwise_max(v0, (f32x4){0.f, 0.f, 0.f, 0.f}); v1 = __builtin_elementwise_max(v1, (f32x4){0.f, 0.f, 0.f, 0.f});
                    st8(rowp + bj * HALF, v0 * v0, v1 * v1); } }
    }
};
struct EpiRes2 {
    static constexpr bool PERM = false, AFTER_DRAIN = false;
    const float* base; float* out; const float* gate; const float* gm2; bf16_t* A2; float* rss;
    __device__ __forceinline__ void operator()(const f32x4 (&acc)[2][2][4][2], const Unit& u, int wr, int wc, int fr, int fq) const {
        typedef unsigned u32x2v __attribute__((ext_vector_type(2)));
        const int col0 = u.pn * BM + wc * 32 + 4 * fq, bidx = (u.pm * BM) >> 13; const float* gp = gate + (size_t)bidx * 6144 + col0; const float* mp = gm2 + bidx * 1024 + col0;
        f32x4 gv[2][2], gm[2][2];
#pragma unroll
        for (int bj = 0; bj < 2; ++bj)
#pragma unroll
            for (int n = 0; n < 2; ++n) { gv[bj][n] = *(const f32x4*)(gp + bj * HALF + n * 16); gm[bj][n] = *(const f32x4*)(mp + bj * HALF + n * 16); }
#pragma unroll
        for (int ai = 0; ai < 2; ++ai)
#pragma unroll
            for (int mh = 0; mh < 2; ++mh) {
                f32x4 xb[2][2][2];
#pragma unroll
                for (int mm = 0; mm < 2; ++mm) { const size_t off = (size_t)(u.pm * BM + ai * HALF + wr * 64 + (2 * mh + mm) * 16 + fr) * 1024 + col0;
#pragma unroll
                    for (int bj = 0; bj < 2; ++bj)
#pragma unroll
                        for (int n = 0; n < 2; ++n) xb[mm][bj][n] = *(const f32x4*)(base + off + bj * HALF + n * 16); }
#pragma unroll
                for (int mm = 0; mm < 2; ++mm) { const int m = 2 * mh + mm; const int row = u.pm * BM + ai * HALF + wr * 64 + m * 16 + fr; const size_t off = (size_t)row * 1024 + col0; float ss = 0.f;
#pragma unroll
                    for (int bj = 0; bj < 2; ++bj)
#pragma unroll
                        for (int n = 0; n < 2; ++n) { const f32x4 x1 = xb[mm][bj][n] + gv[bj][n] * acc[ai][bj][m][n]; *(f32x4*)(out + off + bj * HALF + n * 16) = x1;
                            ss += (x1[0] * x1[0] + x1[1] * x1[1]) + (x1[2] * x1[2] + x1[3] * x1[3]);
                            const f32x4 a2 = x1 * gm[bj][n]; *(u32x2v*)(A2 + off + bj * HALF + n * 16) = (u32x2v){pk2(a2[0], a2[1]), pk2(a2[2], a2[3])}; }
                    ss += __shfl_xor(ss, 16); ss += __shfl_xor(ss, 32);
                    if (fq == 0) __hip_atomic_fetch_add(rss + row, ss, __ATOMIC_RELAXED, __HIP_MEMORY_SCOPE_AGENT); }
            }
    }
};
struct EpiFF1n {
    static constexpr bool PERM = true, AFTER_DRAIN = false;
    bf16_t* F1; const float* rss; const float* c1; float eps;
    __device__ __forceinline__ void operator()(const f32x4 (&acc)[2][2][4][2], const Unit& u, int wr, int wc, int fr, int fq) const {
        const int row0 = u.pm * BM + wr * 64 + fr, col0 = u.pn * BM + wc * 32 + 8 * fq; const float* cp = c1 + (size_t)((u.pm * BM) >> 13) * 4096 + col0;
        f32x4 cv[2][2];
#pragma unroll
        for (int bj = 0; bj < 2; ++bj)
#pragma unroll
            for (int n = 0; n < 2; ++n) cv[bj][n] = *(const f32x4*)(cp + bj * HALF + 4 * n);
        float rs[2][4];
#pragma unroll
        for (int ai = 0; ai < 2; ++ai)
#pragma unroll
            for (int m = 0; m < 4; ++m) rs[ai][m] = __hip_atomic_load(rss + row0 + ai * HALF + m * 16, __ATOMIC_RELAXED, __HIP_MEMORY_SCOPE_AGENT);
#pragma unroll
        for (int ai = 0; ai < 2; ++ai)
#pragma unroll
            for (int m = 0; m < 4; ++m) { bf16_t* rowp = F1 + (size_t)(row0 + ai * HALF + m * 16) * 4096 + col0; const float rstd = rsqrtf(rs[ai][m] * (1.0f / 1024.0f) + eps);
#pragma unroll
                for (int bj = 0; bj < 2; ++bj) { f32x4 v0 = acc[ai][bj][m][0] * rstd + cv[bj][0], v1 = acc[ai][bj][m][1] * rstd + cv[bj][1];
                    v0 = __builtin_elementwise_max(v0, (f32x4){0.f, 0.f, 0.f, 0.f}); v1 = __builtin_elementwise_max(v1, (f32x4){0.f, 0.f, 0.f, 0.f});
                    st8(rowp + bj * HALF, v0 * v0, v1 * v1); } }
    }
};
template <class Epi, class Sched, bool ALIGN_EPI = false, bool SP2 = false>
__device__ __forceinline__ void gemm_phase(PG8_LAS unsigned char* lds, const Gemm g, const Sched& S, const Epi& E) {
    const int tid = threadIdx.x, wid = __builtin_amdgcn_readfirstlane(tid >> 6), lane = tid & 63, wr = wid >> 2, wc = wid & 3, fr = lane & 15, fq = lane >> 4;
    const int K = g.K, nt = K / BK;
    unsigned voffA[2], voffB[2];
#pragma unroll
    for (int i = 0; i < 2; ++i) { int R, C; stage_rc(tid * 16 + i * 8192, R, C); const int Rb = Epi::PERM ? ((R & ~31) + perm32(R & 31)) : R;
        voffA[i] = (unsigned)(R * K + C) * 2u; voffB[i] = (unsigned)(Rb * K + C) * 2u; }
    const size_t kstep = (size_t)(BK * 2);
    const size_t hstep = (size_t)HALF * K * 2;
    const size_t tstep = 2 * hstep;
    const unsigned ldsw = (unsigned)wid * 1024u;
    const int aoff = lds_byte(wr * 64 + fr, fq * 8), boff = lds_byte(wc * 32 + fr, fq * 8);
#define PG8_SA(b, h) (((b) * 2 + (h)) * HTB)
#define PG8_SB(b, h) ((4 + (b) * 2 + (h)) * HTB)
#define PG8_STAGE(bufoff, gbase, voff) do { _Pragma("unroll") for (int _i = 0; _i < 2; ++_i) \
        __builtin_amdgcn_global_load_lds((const unsigned*)((const char*)(gbase) + (voff)[_i]), (PG8_LAS unsigned*)(lds + (bufoff) + ldsw + _i * 8192), 16, 0, 0); } while (0)
#define PG8_LDA(dst, b, h) do { _Pragma("unroll") for (int m = 0; m < 4; ++m) _Pragma("unroll") for (int k = 0; k < 2; ++k) dst[m][k] = *(const PG8_LAS bf16x8*)(lds + PG8_SA(b, h) + aoff + m * 2048 + k * 1024); } while (0)
#define PG8_LDB(dst, b, h) do { _Pragma("unroll") for (int n = 0; n < 2; ++n) _Pragma("unroll") for (int k = 0; k < 2; ++k) dst[n][k] = *(const PG8_LAS bf16x8*)(lds + PG8_SB(b, h) + boff + n * 2048 + k * 1024); } while (0)
#define PG8_MMA(ai, bj, At, Bt) do { __builtin_amdgcn_s_setprio(1); _Pragma("unroll") for (int m = 0; m < 4; ++m) _Pragma("unroll") for (int n = 0; n < 2; ++n) _Pragma("unroll") for (int k = 0; k < 2; ++k) \
        acc[ai][bj][m][n] = __builtin_amdgcn_mfma_f32_16x16x32_bf16(Bt[n][k], At[m][k], acc[ai][bj][m][n], 0, 0, 0); __builtin_amdgcn_s_setprio(0); } while (0)
#define PG8_WAIT_V(n) asm volatile("s_waitcnt vmcnt(" #n ")" ::: "memory")
#define PG8_WAIT_L(n) asm volatile("s_waitcnt lgkmcnt(" #n ")" ::: "memory")
#define PG8_BAR __builtin_amdgcn_s_barrier()
#define PG8_SCHED __builtin_amdgcn_sched_barrier(0)
    Unit cur, nxt; int ui = 0;
    if (!S.next(0, cur)) return;
    f32x4 acc[2][2][4][2];
#pragma unroll
    for (int a = 0; a < 2; ++a)
#pragma unroll
        for (int b = 0; b < 2; ++b)
#pragma unroll
            for (int m = 0; m < 4; ++m)
#pragma unroll
                for (int n = 0; n < 2; ++n) acc[a][b][m][n] = (f32x4){0.f, 0.f, 0.f, 0.f};
    bf16x8 At[4][2], B0[2][2], B1[2][2];
    const char* cA = (const char*)g.A + (size_t)cur.pm * tstep; const char* cB = (const char*)g.Bt + (size_t)cur.pn * tstep;
    S.a_ready(cur);
    if constexpr (SP2) {
        PG8_STAGE(PG8_SB(0, 0), cB, voffB); PG8_STAGE(PG8_SB(0, 1), cB + hstep, voffB); PG8_STAGE(PG8_SA(0, 0), cA, voffA); PG8_STAGE(PG8_SA(0, 1), cA + hstep, voffA);
        if (wr == 1) PG8_BAR;
        PG8_WAIT_V(2); PG8_BAR;
        PG8_STAGE(PG8_SB(1, 0), cB + kstep, voffB); PG8_STAGE(PG8_SA(1, 0), cA + kstep, voffA); PG8_STAGE(PG8_SB(1, 1), cB + hstep + kstep, voffB);
        PG8_WAIT_V(6); PG8_BAR;
    } else {
        PG8_STAGE(PG8_SB(0, 0), cB, voffB); PG8_STAGE(PG8_SA(0, 0), cA, voffA); PG8_STAGE(PG8_SB(0, 1), cB + hstep, voffB); PG8_STAGE(PG8_SA(0, 1), cA + hstep, voffA);
        if (wr == 1) PG8_BAR;
        PG8_WAIT_V(4); PG8_BAR;
        PG8_STAGE(PG8_SB(1, 0), cB + kstep, voffB); PG8_STAGE(PG8_SA(1, 0), cA + kstep, voffA); PG8_STAGE(PG8_SB(1, 1), cB + hstep + kstep, voffB);
        PG8_WAIT_V(6); PG8_BAR;
    }
    for (;;) {
        const bool has_next = S.next(ui + 1, nxt);
        const char* nA = has_next ? (const char*)g.A + (size_t)nxt.pm * tstep : cA; const char* nB = has_next ? (const char*)g.Bt + (size_t)nxt.pn * tstep : cB;
        for (int t = 0; t < nt; t += 2) {
            const bool last = (t == nt - 2);
            const char* a1 = cA + (size_t)(t + 1) * kstep;
            const char* a2 = last ? nA : cA + (size_t)(t + 2) * kstep; const char* b2 = last ? nB : cB + (size_t)(t + 2) * kstep;
            const char* a3 = a2 + kstep; const char* b3 = b2 + kstep;
            if (last && has_next) S.a_ready(nxt);
            if constexpr (SP2) {
            PG8_LDB(B0, 0, 0); PG8_LDB(B1, 0, 1); PG8_SCHED; PG8_LDA(At, 0, 0); PG8_STAGE(PG8_SA(1, 1), a1 + hstep, voffA);
            PG8_WAIT_V(8); PG8_WAIT_L(0); PG8_BAR; PG8_MMA(0, 0, At, B0); PG8_MMA(0, 1, At, B1); PG8_BAR; PG8_SCHED;
            PG8_LDA(At, 0, 1); PG8_STAGE(PG8_SB(0, 0), b2, voffB); PG8_STAGE(PG8_SB(0, 1), b2 + hstep, voffB); PG8_STAGE(PG8_SA(0, 0), a2, voffA);
            PG8_WAIT_V(8); PG8_WAIT_L(0); PG8_BAR; PG8_MMA(1, 0, At, B0); PG8_MMA(1, 1, At, B1); PG8_BAR; PG8_SCHED;
            PG8_LDB(B0, 1, 0); PG8_LDB(B1, 1, 1); PG8_SCHED; PG8_LDA(At, 1, 0); PG8_STAGE(PG8_SA(0, 1), a2 + hstep, voffA);
            PG8_WAIT_V(8); PG8_WAIT_L(0); PG8_BAR; PG8_MMA(0, 0, At, B0); PG8_MMA(0, 1, At, B1); PG8_BAR; PG8_SCHED;
            PG8_LDA(At, 1, 1); PG8_STAGE(PG8_SB(1, 0), b3, voffB); PG8_STAGE(PG8_SB(1, 1), b3 + hstep, voffB); PG8_STAGE(PG8_SA(1, 0), a3, voffA);
            PG8_WAIT_V(8); PG8_WAIT_L(0); PG8_BAR; PG8_MMA(1, 0, At, B0); PG8_MMA(1, 1, At, B1); PG8_BAR; PG8_SCHED;
            } else {
            PG8_LDB(B0, 0, 0); PG8_SCHED; PG8_LDA(At, 0, 0); PG8_STAGE(PG8_SA(1, 1), a1 + hstep, voffA);
            PG8_WAIT_L(8); PG8_BAR; PG8_WAIT_L(0); PG8_MMA(0, 0, At, B0); PG8_BAR; PG8_SCHED;
            PG8_LDB(B1, 0, 1); PG8_STAGE(PG8_SB(0, 0), b2, voffB);
            PG8_BAR; PG8_WAIT_L(0); PG8_MMA(0, 1, At, B1); PG8_BAR;
            PG8_LDA(At, 0, 1); PG8_STAGE(PG8_SA(0, 0), a2, voffA);
            PG8_BAR; PG8_WAIT_L(0); PG8_MMA(1, 0, At, B0); PG8_BAR; PG8_SCHED;
            PG8_STAGE(PG8_SB(0, 1), b2 + hstep, voffB);
            PG8_WAIT_V(6); PG8_BAR; PG8_MMA(1, 1, At, B1); PG8_BAR;
            PG8_LDB(B0, 1, 0); PG8_SCHED; PG8_LDA(At, 1, 0); PG8_STAGE(PG8_SA(0, 1), a2 + hstep, voffA);
            PG8_WAIT_L(8); PG8_BAR; PG8_WAIT_L(0); PG8_MMA(0, 0, At, B0); PG8_BAR; PG8_SCHED;
            PG8_LDB(B1, 1, 1); PG8_STAGE(PG8_SB(1, 0), b3, voffB);
            PG8_BAR; PG8_WAIT_L(0); PG8_MMA(0, 1, At, B1); PG8_BAR;
            PG8_LDA(At, 1, 1); PG8_STAGE(PG8_SA(1, 0), a3, voffA);
            PG8_BAR; PG8_WAIT_L(0); PG8_MMA(1, 0, At, B0); PG8_BAR; PG8_SCHED;
            PG8_STAGE(PG8_SB(1, 1), b3 + hstep, voffB);
            PG8_WAIT_V(6); PG8_BAR; PG8_MMA(1, 1, At, B1); PG8_BAR;
            }
        }
        if constexpr (ALIGN_EPI) { if (wr == 0) PG8_BAR; }
        if constexpr (!Epi::AFTER_DRAIN) { E(acc, cur, wr, wc, fr, fq); S.done(cur); }
        if (!has_next) break;
#pragma unroll
        for (int a = 0; a < 2; ++a)
#pragma unroll
            for (int b = 0; b < 2; ++b)
#pragma unroll
                for (int m = 0; m < 4; ++m)
#pragma unroll
                    for (int n = 0; n < 2; ++n) acc[a][b][m][n] = (f32x4){0.f, 0.f, 0.f, 0.f};
        cur = nxt; cA = nA; cB = nB; ++ui;
        if constexpr (ALIGN_EPI) { if (wr == 1) PG8_BAR; }
    }
    PG8_WAIT_V(0);
    if constexpr (!ALIGN_EPI) { if (wr == 0) PG8_BAR; }
    PG8_BAR;
    if constexpr (Epi::AFTER_DRAIN) { E.fused(acc, cur, wr, wc, fr, fq, lds, wid, lane); S.done(cur); }
#undef PG8_SA
#undef PG8_SB
#undef PG8_STAGE
#undef PG8_LDA
#undef PG8_LDB
#undef PG8_MMA
#undef PG8_WAIT_V
#undef PG8_WAIT_L
#undef PG8_BAR
#undef PG8_SCHED
}
}

constexpr int NWAVES = 8;
#ifndef MK_N_LAUNCHES
#define MK_N_LAUNCHES 1
#endif
constexpr int N_LAUNCHES = MK_N_LAUNCHES;
constexpr int N_PHASES = 12;
#ifndef FUSE_NORM
#define FUSE_NORM 1
#endif

constexpr int BATCH = 4, SEQ = 8192, D = 1024, M = BATCH * SEQ, FF = 4096, DIN = 7184;
constexpr int NCH = SEQ / 64, NSEG = 16, SEGCH = NCH / NSEG;
constexpr float EPS = 1e-6f;

constexpr size_t MiB = 1u << 20;
constexpr size_t WS_CTL = 0, CTL_ZERO_BYTES = 1 * MiB;
constexpr size_t WS_MOD = 1 * MiB, WS_WLR = 1 * MiB + 128 * 1024, WS_GM2 = 1 * MiB + 192 * 1024, WS_C1 = 1 * MiB + 256 * 1024, WS_RSS = 1 * MiB + 512 * 1024;
constexpr size_t WS_W1T = 2 * MiB, WS_WVT = 14 * MiB, WS_WCT = 16 * MiB, WS_WGT = 18 * MiB, WS_WOT = 20 * MiB, WS_WF1T = 22 * MiB, WS_WF2T = 30 * MiB;
constexpr size_t WS_PLR = 38 * MiB;
constexpr size_t WS_U = 40 * MiB;
constexpr size_t WS_Q = 104 * MiB, WS_K = 136 * MiB, WS_VT = 168 * MiB, WS_SG = 232 * MiB, WS_GT = 296 * MiB;
constexpr size_t WS_EST = 424 * MiB, WS_DSEG = 456 * MiB, WS_END = 457 * MiB;
constexpr size_t WS_F1 = 104 * MiB, WS_H2 = 360 * MiB;
constexpr size_t OUT_GC = 64 * MiB;
constexpr int CW_BAR = 4096;

constexpr int RING_OFF = 0, RING_BYTES = 131072;
constexpr int LDSCTL_OFF = 148480, MISC_OFF = LDSCTL_OFF + 320;
constexpr int LDS_BYTES = 149504;

#define GAS __attribute__((address_space(1)))
#define LAS __attribute__((address_space(3)))
#define DI __device__ __forceinline__
typedef unsigned short bf16;
typedef float f32x4 __attribute__((ext_vector_type(4)));
typedef float f32x2 __attribute__((ext_vector_type(2)));
typedef float f32x16 __attribute__((ext_vector_type(16)));
typedef unsigned u32x4 __attribute__((ext_vector_type(4)));
typedef unsigned u32x2 __attribute__((ext_vector_type(2)));
typedef short bf16x8 __attribute__((ext_vector_type(8)));
typedef GAS unsigned gu32;
#define RLX_AGENT __ATOMIC_RELAXED, __HIP_MEMORY_SCOPE_AGENT
using pg8::pk2; using pg8::bf_lo; using pg8::bf_hi; using pg8::sigm;

#define XB_TMO      128
#define XB_XCNT(j)  (256  + 64 * (j))
#define XB_XSUB(j)  (1280 + 64 * (j))
#define XB_XGEN(j)  (2304 + 64 * (j))
#define XB_TOP      3328
#define XB_TOPGEN   3392
#define XCD_BAR_WORDS 3456
#define XB_SPIN_CAP (1u << 18)

__device__ __forceinline__ unsigned xb_ld(unsigned* p)              { return __hip_atomic_load(p, __ATOMIC_RELAXED, __HIP_MEMORY_SCOPE_AGENT); }
__device__ __forceinline__ unsigned xb_add(unsigned* p, unsigned v) { return __hip_atomic_fetch_add(p, v, __ATOMIC_RELAXED, __HIP_MEMORY_SCOPE_AGENT); }
__device__ __forceinline__ unsigned xb_xcc_id() { return (unsigned)__builtin_amdgcn_s_getreg((3 << 11) | 20) & 0xFu; }
#define XB_SPIN(cond, bar) do { unsigned _sp = 0; while (cond) { __builtin_amdgcn_s_sleep(1); \
    if ((++_sp & 255u) == 0u) { if (xb_ld(&(bar)[XB_TMO])) break; if (_sp > XB_SPIN_CAP) { atomicAdd(&(bar)[XB_TMO], 1u); break; } } } } while (0)

struct XcdBarrier {
    unsigned* bar; unsigned x;
    volatile LAS unsigned* st;
};

__device__ __forceinline__ XcdBarrier xcd_barrier_post(unsigned* bar, volatile LAS unsigned* st) {
    XcdBarrier b; b.bar = bar; b.x = xb_xcc_id(); b.st = st;
    if (threadIdx.x == 0) (void)xb_add(&bar[XB_XCNT(b.x)], 1u);
    return b;
}
__device__ __forceinline__ void xcd_barrier_complete(unsigned* bar, unsigned x, unsigned& nloc, unsigned& nx) {
    const unsigned G = gridDim.x * gridDim.y * gridDim.z;
    unsigned sum, cnt, mine, sp = 0u;
    for (;;) {
        sum = 0u; cnt = 0u; mine = 0u;
#pragma unroll
        for (unsigned j = 0; j < 16; ++j) { const unsigned c = xb_ld(&bar[XB_XCNT(j)]); sum += c; cnt += (c > 0u) ? 1u : 0u; mine = (j == x) ? c : mine; }
        if (sum == G) break;
        __builtin_amdgcn_s_sleep(1);
        if ((++sp & 255u) == 0u) { if (xb_ld(&bar[XB_TMO])) break; if (sp > XB_SPIN_CAP) { atomicAdd(&bar[XB_TMO], 1u); break; } }
    }
    nloc = mine > 0u ? mine : 1u; nx = cnt > 0u ? cnt : 1u;
}

__device__ __forceinline__ void xcd_barrier(const XcdBarrier& b) {
    asm volatile("s_waitcnt vmcnt(0)" ::: "memory");
    __syncthreads();
    if (threadIdx.x == 0) {
        unsigned* bar = b.bar;
        __builtin_amdgcn_s_waitcnt(0);
        unsigned nloc = b.st[0], nx = b.st[1];
        if (nloc == 0u) { xcd_barrier_complete(bar, b.x, nloc, nx); b.st[0] = nloc; b.st[1] = nx; }
        const unsigned old = xb_add(&bar[XB_XSUB(b.x)], 1u);
        const unsigned gen = old / nloc;
        if (old + 1u == (gen + 1u) * nloc) {
            __builtin_amdgcn_fence(__ATOMIC_RELEASE, "agent");
            asm volatile("s_waitcnt vmcnt(0)" ::: "memory");
            const unsigned og = xb_add(&bar[XB_TOP], 1u);
            const unsigned tg = og / nx;
            if (og + 1u == (tg + 1u) * nx) xb_add(&bar[XB_TOPGEN], 1u);
            else XB_SPIN(xb_ld(&bar[XB_TOPGEN]) == tg, bar);
            __builtin_amdgcn_fence(__ATOMIC_ACQUIRE, "agent");
            xb_add(&bar[XB_XGEN(b.x)], 1u);
            asm volatile("s_waitcnt vmcnt(0)" ::: "memory");
        } else {
            XB_SPIN(xb_ld(&bar[XB_XGEN(b.x)]) == gen, bar);
            __builtin_amdgcn_fence(__ATOMIC_ACQUIRE, "agent");
            asm volatile("s_waitcnt vmcnt(0)" ::: "memory");
        }
    }
    __syncthreads();
}


DI float wave_sum(float v) {
#pragma unroll
    for (int o = 1; o < 64; o <<= 1) v += __shfl_xor(v, o);
    return v;
}
template <int N, int SZ> DI void bstep(float (&v)[SZ], int lane) {
    const bool up = (lane & N) != 0;
#pragma unroll
    for (int i = 0; i < N; ++i) { const float a = v[i], b = v[i + N]; const float keep = up ? b : a, send = up ? a : b; v[i] = keep + __shfl_xor(send, N); }
}

DI void tr_item(const float* W, int ldw, int K, bf16* WT, int src_c0, int dst_r0, int k0, LAS float* scr, int lane) {
#pragma unroll 8
    for (int i = 0; i < 32; ++i) { const int kk = 2 * i + (lane >> 5); scr[kk * 33 + (lane & 31)] = W[(size_t)(k0 + kk) * ldw + src_c0 + (lane & 31)]; }
    asm volatile("s_waitcnt lgkmcnt(0)" ::: "memory");
    const int c = lane & 7;
#pragma unroll
    for (int j = 0; j < 4; ++j) { const int n = (lane >> 3) + 8 * j; const LAS float* s = scr + (8 * c) * 33 + n;
        u32x4 o; o.x = pk2(s[0 * 33], s[1 * 33]); o.y = pk2(s[2 * 33], s[3 * 33]); o.z = pk2(s[4 * 33], s[5 * 33]); o.w = pk2(s[6 * 33], s[7 * 33]);
        *(u32x4*)(WT + (size_t)(dst_r0 + n) * K + k0 + 8 * c) = o; }
    asm volatile("s_waitcnt lgkmcnt(0)" ::: "memory");
}
DI int g1_src_col(int grp) {
    const int tile = grp >> 3, within = (grp & 7) * 32;
    if (tile < 8) return within < 128 ? 128 * tile + within : 1024 + 128 * tile + (within - 128);
    if (tile < 12) return 32 * grp;
    if (tile < 16) return 4096 + (32 * grp - 3072);
    return 5136 + (32 * grp - 4096);
}
struct P0Args { const float *c, *w_ada, *b_ada, *w_in, *w_conv_out, *w_gla_out, *w_o, *w_ff1, *w_ff2; float* mod; bf16 *W1T, *WVT, *WLR, *WCT, *WGT, *WOT, *WF1T, *WF2T; };
DI void p0_prologue(LAS unsigned char* lds, int vcu, int G, int tid, int lane, int wave, const P0Args& a) {
    if (vcu < 192) {
        LAS float* sc = (LAS float*)lds;
        for (int i = tid; i < 4096; i += 512) { const float v = a.c[i]; sc[i] = v * sigm(v); }
        __syncthreads();
        const int col = tid & 31, kq = tid >> 5, n = 32 * vcu + col;
        float a0 = 0.f, a1 = 0.f, a2 = 0.f, a3 = 0.f;
#pragma unroll 8
        for (int i = 0; i < 64; ++i) { const int k = kq + 16 * i; const float w = a.w_ada[(size_t)k * 6144 + n]; a0 += sc[k] * w; a1 += sc[1024 + k] * w; a2 += sc[2048 + k] * w; a3 += sc[3072 + k] * w; }
        LAS float* red = (LAS float*)(lds + 16384);
        red[(kq * 4 + 0) * 32 + col] = a0; red[(kq * 4 + 1) * 32 + col] = a1; red[(kq * 4 + 2) * 32 + col] = a2; red[(kq * 4 + 3) * 32 + col] = a3;
        __syncthreads();
        if (tid < 128) { const int b = tid >> 5, cc = tid & 31; float s = a.b_ada[32 * vcu + cc];
#pragma unroll
            for (int q = 0; q < 16; ++q) s += red[(q * 4 + b) * 32 + cc];
            a.mod[b * 6144 + 32 * vcu + cc] = s; }
        __syncthreads();
    }
    if (vcu == G - 1) for (int i = tid; i < 16384; i += 512) { const int r = i >> 10, k = i & 1023; a.WLR[i] = (bf16)(pk2(a.w_in[(size_t)k * DIN + 5120 + r], 0.f) & 0xffffu); }
    LAS float* scr = (LAS float*)(lds + wave * 16384);
    const int gw = vcu * NWAVES + wave, NGW = G * NWAVES;
    constexpr int I1 = 192 * 16, IV = 32 * 16, IS = 32 * 16, IF1 = 128 * 16, IF2 = 32 * 64, NITEMS = I1 + IV + 3 * IS + IF1 + IF2;
    for (int it = gw; it < NITEMS; it += NGW) {
        int r = it;
        if (r < I1) { const int kb = r / 192, grp = r % 192; tr_item(a.w_in, DIN, D, a.W1T, g1_src_col(grp), 32 * grp, 64 * kb, scr, lane); continue; } r -= I1;
        if (r < IV) { const int kb = r / 32, grp = r % 32; tr_item(a.w_in, DIN, D, a.WVT, 3072 + 32 * grp, 32 * grp, 64 * kb, scr, lane); continue; } r -= IV;
        if (r < IS) { const int kb = r / 32, grp = r % 32; tr_item(a.w_conv_out, D, D, a.WCT, 32 * grp, 32 * grp, 64 * kb, scr, lane); continue; } r -= IS;
        if (r < IS) { const int kb = r / 32, grp = r % 32; tr_item(a.w_gla_out, D, D, a.WGT, 32 * grp, 32 * grp, 64 * kb, scr, lane); continue; } r -= IS;
        if (r < IS) { const int kb = r / 32, grp = r % 32; tr_item(a.w_o, D, D, a.WOT, 32 * grp, 32 * grp, 64 * kb, scr, lane); continue; } r -= IS;
        if (r < IF1) { const int kb = r / 128, grp = r % 128; tr_item(a.w_ff1, FF, D, a.WF1T, 32 * grp, 32 * grp, 64 * kb, scr, lane); continue; } r -= IF1;
        { const int kb = r / 32, grp = r % 32; tr_item(a.w_ff2, D, FF, a.WF2T, 32 * grp, 32 * grp, 64 * kb, scr, lane); }
    }
}

template <bool WITH_LR>
DI void p_norm(LAS unsigned char* lds, int vcu, int tid, int lane, int wave, const float* src, const float* g, const float* modb, int sc_off, int sh_off, bf16* dst, const bf16* WLR, float* PLR) {
    const int rowbase = vcu * 128; const float* mb = modb + (size_t)(rowbase >> 13) * 6144;
    f32x4 gm[4], sh[4];
#pragma unroll
    for (int j = 0; j < 4; ++j) { const int col = 4 * lane + 256 * j; const f32x4 gv = *(const f32x4*)(g + col), sv = *(const f32x4*)(mb + sc_off + col); gm[j] = gv * (sv + 1.0f); sh[j] = *(const f32x4*)(mb + sh_off + col); }
    for (int sb = 0; sb < 4; ++sb) {
        f32x4 v[4][4];
#pragma unroll
        for (int rr = 0; rr < 4; ++rr)
#pragma unroll
            for (int j = 0; j < 4; ++j) v[rr][j] = *(const f32x4*)(src + (size_t)(rowbase + 32 * sb + 4 * wave + rr) * D + 4 * lane + 256 * j);
#pragma unroll
        for (int rr = 0; rr < 4; ++rr) {
            const int lr = 4 * wave + rr; const size_t row = (size_t)(rowbase + 32 * sb + lr);
            float ss = 0.f;
#pragma unroll
            for (int j = 0; j < 4; ++j) ss += (v[rr][j].x * v[rr][j].x + v[rr][j].y * v[rr][j].y) + (v[rr][j].z * v[rr][j].z + v[rr][j].w * v[rr][j].w);
            const float rstd = rsqrtf(wave_sum(ss) * (1.0f / D) + EPS);
#pragma unroll
            for (int j = 0; j < 4; ++j) { const f32x4 o = v[rr][j] * rstd * gm[j] + sh[j]; u32x2 p; p.x = pk2(o.x, o.y); p.y = pk2(o.z, o.w);
                *(u32x2*)(dst + row * D + 4 * lane + 256 * j) = p;
                if (WITH_LR) *(LAS u32x2*)(lds + lr * 2064 + (4 * lane + 256 * j) * 2) = p; }
        }
        if (WITH_LR) {
            __syncthreads();
            const int rt = wave & 1, kq = wave >> 1, fr = lane & 15, fq = lane >> 4;
            f32x4 acc = (f32x4){0.f, 0.f, 0.f, 0.f};
#pragma unroll
            for (int s = 0; s < 8; ++s) { const int ks = 8 * kq + s;
                const bf16x8 A = *(const LAS bf16x8*)(lds + (16 * rt + fr) * 2064 + (32 * ks + 8 * fq) * 2);
                const bf16x8 B = *(const bf16x8*)(WLR + fr * 1024 + 32 * ks + 8 * fq);
                acc = __builtin_amdgcn_mfma_f32_16x16x32_bf16(A, B, acc, 0, 0, 0); }
            LAS float* red = (LAS float*)(lds + 67584);
#pragma unroll
            for (int i = 0; i < 4; ++i) red[((kq * 2 + rt) * 16 + (4 * fq + i)) * 16 + fr] = acc[i];
            __syncthreads();
            { const int rt2 = tid >> 8, rc = tid & 255; float s = 0.f;
#pragma unroll
              for (int q = 0; q < 4; ++q) s += red[(q * 2 + rt2) * 256 + rc];
              PLR[(size_t)(rowbase + 32 * sb + 16 * rt2 + (rc >> 4)) * 16 + (rc & 15)] = s; }
        }
    }
}
DI void p1_tables(LAS unsigned char* lds, int vcu, int tid, const float* mod, const float* g_mlp, const float* w_ff1, float* GM2, float* C1, float* RSS) {
    if (tid < 128) RSS[vcu * 128 + tid] = 0.f;
    if (vcu < 8) { const int i = vcu * 512 + tid, b = i >> 10, c = i & 1023; GM2[i] = g_mlp[c] * (1.0f + mod[b * 6144 + 4096 + c]); }
    if (vcu >= 128) {
        const int v = vcu - 128; LAS float* shl = (LAS float*)lds;
        __syncthreads();
        for (int i = tid; i < 4096; i += 512) shl[i] = mod[(i >> 10) * 6144 + 3072 + (i & 1023)];
        __syncthreads();
        const int col = tid & 31, kq = tid >> 5, n = 32 * v + col;
        float a0 = 0.f, a1 = 0.f, a2 = 0.f, a3 = 0.f;
#pragma unroll 8
        for (int i = 0; i < 64; ++i) { const int k = kq + 16 * i; const float w = w_ff1[(size_t)k * FF + n]; a0 += shl[k] * w; a1 += shl[1024 + k] * w; a2 += shl[2048 + k] * w; a3 += shl[3072 + k] * w; }
        LAS float* red = (LAS float*)(lds + 16384);
        red[(kq * 4 + 0) * 32 + col] = a0; red[(kq * 4 + 1) * 32 + col] = a1; red[(kq * 4 + 2) * 32 + col] = a2; red[(kq * 4 + 3) * 32 + col] = a3;
        __syncthreads();
        if (tid < 128) { const int b = tid >> 5, cc = tid & 31; float s = 0.f;
#pragma unroll
            for (int q = 0; q < 16; ++q) s += red[(q * 4 + b) * 32 + cc];
            C1[b * FF + 32 * v + cc] = s; }
        __syncthreads();
    }
}
DI void p_final(int vcu, int lane, int wave, float* xio, const float* g) {
    f32x4 gv[4];
#pragma unroll
    for (int j = 0; j < 4; ++j) gv[j] = *(const f32x4*)(g + 4 * lane + 256 * j);
    for (int i0 = 0; i0 < 16; i0 += 4) {
        f32x4 v[4][4];
#pragma unroll
        for (int i = 0; i < 4; ++i)
#pragma unroll
            for (int j = 0; j < 4; ++j) v[i][j] = *(const f32x4*)(xio + (size_t)(vcu * 128 + 16 * wave + i0 + i) * D + 4 * lane + 256 * j);
#pragma unroll
        for (int i = 0; i < 4; ++i) { const size_t row = (size_t)(vcu * 128 + 16 * wave + i0 + i); float ss = 0.f;
#pragma unroll
            for (int j = 0; j < 4; ++j) ss += (v[i][j].x * v[i][j].x + v[i][j].y * v[i][j].y) + (v[i][j].z * v[i][j].z + v[i][j].w * v[i][j].w);
            const float rstd = rsqrtf(wave_sum(ss) * (1.0f / D) + EPS);
#pragma unroll
            for (int j = 0; j < 4; ++j) *(f32x4*)(xio + row * D + 4 * lane + 256 * j) = v[i][j] * rstd * gv[j];
        }
    }
}

template <int J> DI void conv_one(f32x2 (&acc)[32], const f32x2 (&w)[31], const unsigned* up, bool first) {
    unsigned raw = 0u; if (J >= 30 || !first) raw = up[(long)J * 512];
    const f32x2 in = (f32x2){bf_lo(raw), bf_hi(raw)};
#pragma unroll
    for (int k = 0; k < 31; ++k) { const int t = J - k; if (t >= 0 && t < 32) acc[t] += w[k] * in; }
}
template <int... Js> DI void conv_all(std::integer_sequence<int, Js...>, f32x2 (&acc)[32], const f32x2 (&w)[31], const unsigned* up, bool first) { (conv_one<Js>(acc, w, up, first), ...); }
DI void p_conv(LAS unsigned char* lds, int vcu, int tid, int lane, int wave, const bf16* U, const float* w_dw, const float* b_dw, const float* g_cln, const float* b_cln, bf16* UC) {
    const int cp = tid;
    f32x2 w[31];
#pragma unroll
    for (int k = 0; k < 31; ++k) w[k] = *(const f32x2*)(w_dw + k * 1024 + 2 * cp);
    const f32x2 bias = *(const f32x2*)(b_dw + 2 * cp), gl = *(const f32x2*)(g_cln + 2 * cp), bl = *(const f32x2*)(b_cln + 2 * cp);
    LAS float* part = (LAS float*)lds;
    LAS f32x2* stats = (LAS f32x2*)(lds + 2048);
    for (int si = 0; si < 4; ++si) {
        const int r0 = (vcu * 4 + si) * 32; const bool first = (r0 & (SEQ - 1)) == 0;
        f32x2 acc[32];
#pragma unroll
        for (int t = 0; t < 32; ++t) acc[t] = bias;
        const unsigned* up = (const unsigned*)U + ((long)r0 - 30) * 512 + cp;
        conv_all(std::make_integer_sequence<int, 62>{}, acc, w, up, first);
        float v[64];
#pragma unroll
        for (int t = 0; t < 32; ++t) { v[t] = acc[t].x + acc[t].y; v[32 + t] = acc[t].x * acc[t].x + acc[t].y * acc[t].y; }
        bstep<32, 64>(v, lane); bstep<16, 64>(v, lane); bstep<8, 64>(v, lane); bstep<4, 64>(v, lane); bstep<2, 64>(v, lane); bstep<1, 64>(v, lane);
        part[wave * 64 + lane] = v[0];
        __syncthreads();
        if (tid < 32) { float s1 = 0.f, s2 = 0.f;
#pragma unroll
            for (int q = 0; q < 8; ++q) { s1 += part[q * 64 + tid]; s2 += part[q * 64 + 32 + tid]; }
            const float mean = s1 * (1.0f / 1024.0f), var = s2 * (1.0f / 1024.0f) - mean * mean; stats[tid] = (f32x2){mean, rsqrtf(var + EPS)}; }
        __syncthreads();
        unsigned* op = (unsigned*)UC + (size_t)r0 * 512 + cp;
#pragma unroll
        for (int t = 0; t < 32; ++t) { const f32x2 st = stats[t]; float y0 = (acc[t].x - st.x) * st.y * gl.x + bl.x, y1 = (acc[t].y - st.x) * st.y * gl.y + bl.y;
            y0 *= sigm(y0); y1 *= sigm(y1); op[(size_t)t * 512] = pk2(y0, y1); }
    }
}

constexpr int GL_QH = 0, GL_KH = 17408, GL_KT = 34816, GL_OT = 0  , GL_RAWK = 0  ,
              GL_VT = 53248  , GL_PLR = 118784  , GL_TOT = 126976, GL_LA32 = 129024, GL_EREF = 129536, GL_ELAST = 130048,
              GL_PART = 130560, GL_RS = 132608, GL_WA2 = 132864, GL_BA2 = 141056, GL_PF = 141568, GL_END = 147712;
static_assert(GL_END <= LDSCTL_OFF, "GLA LDS map");
typedef short s16x4 __attribute__((ext_vector_type(4)));
DI bf16x8 frag2(const LAS unsigned char* p) {
    const s16x4 lo = *(const LAS s16x4*)p, hi = *(const LAS s16x4*)(p + 16);
    return __builtin_shufflevector(lo, hi, 0, 1, 2, 3, 4, 5, 6, 7);
}
DI bf16x8 frag2p(const LAS unsigned char* p0, const LAS unsigned char* p1) { const s16x4 lo = *(const LAS s16x4*)p0, hi = *(const LAS s16x4*)p1; return __builtin_shufflevector(lo, hi, 0, 1, 2, 3, 4, 5, 6, 7); }
DI bf16x8 pack8(const f32x16& x, int s) {
    u32x4 p; p.x = pk2(x[8 * s], x[8 * s + 1]); p.y = pk2(x[8 * s + 2], x[8 * s + 3]); p.z = pk2(x[8 * s + 4], x[8 * s + 5]); p.w = pk2(x[8 * s + 6], x[8 * s + 7]);
    return __builtin_bit_cast(bf16x8, p);
}
DI float fexp(float x) { return __builtin_amdgcn_exp2f(x * 1.4426950408889634f); }
DI float flog(float x) { return __builtin_amdgcn_logf(x) * 0.6931471805599453f; }
#define MFMA32(a, b, c) __builtin_amdgcn_mfma_f32_32x32x16_bf16((a), (b), (c), 0, 0, 0)
#define BARL() do { asm volatile("s_waitcnt lgkmcnt(0)" ::: "memory"); __builtin_amdgcn_s_barrier(); asm volatile("" ::: "memory"); } while (0)
#define VMW0() asm volatile("s_waitcnt vmcnt(0)" ::: "memory")
struct GlaArgs { const bf16 *Q, *K, *VT, *SG; const float *PLR, *w_a2, *b_a2, *g_gla; float *EST, *DSEG; bf16* O2; };
template <int PASS>
DI void p_gla(LAS unsigned char* lds, int vcu, int tid, int lane, int wave, const GlaArgs& a) {
    const int item = vcu, bh = item >> 4, seg = item & 15, b = bh >> 2, h = bh & 3;
    const int d = tid & 127, tq = tid >> 7, r = lane & 31, hh = lane >> 5, w = wave;
    f32x16 S[4];
    float* est = a.EST + (size_t)item * 32768;
#pragma unroll
    for (int kb = 0; kb < 4; ++kb)
#pragma unroll
        for (int g = 0; g < 4; ++g) { f32x4 v = (f32x4){0.f, 0.f, 0.f, 0.f}; if (PASS == 2) v = *(const f32x4*)(est + (size_t)(((w * 4 + kb) * 4 + g) * 64 + lane) * 4);
            S[kb][4 * g] = v.x; S[kb][4 * g + 1] = v.y; S[kb][4 * g + 2] = v.z; S[kb][4 * g + 3] = v.w; }
    float dsum = 0.f;
    LAS float* BA2 = (LAS float*)(lds + GL_BA2);
    if (tid < 256) {
        const int db = tid >> 6, l = tid & 63; float wv[8];
#pragma unroll
        for (int j = 0; j < 8; ++j) wv[j] = a.w_a2[(8 * (l >> 5) + j) * 512 + h * 128 + 32 * db + (l & 31)];
        u32x4 hi, lo; unsigned hp[4];
#pragma unroll
        for (int j = 0; j < 4; ++j) { hp[j] = pk2(wv[2 * j], wv[2 * j + 1]); }
        hi = (u32x4){hp[0], hp[1], hp[2], hp[3]};
        lo = (u32x4){pk2(wv[0] - bf_lo(hp[0]), wv[1] - bf_hi(hp[0])), pk2(wv[2] - bf_lo(hp[1]), wv[3] - bf_hi(hp[1])), pk2(wv[4] - bf_lo(hp[2]), wv[5] - bf_hi(hp[2])), pk2(wv[6] - bf_lo(hp[3]), wv[7] - bf_hi(hp[3]))};
        *(LAS u32x4*)(lds + GL_WA2 + ((db * 2 + 0) * 64 + l) * 16) = hi; *(LAS u32x4*)(lds + GL_WA2 + ((db * 2 + 1) * 64 + l) * 16) = lo;
    }
    if (tq == 0) BA2[d] = a.b_a2[h * 128 + d];
    LAS float* TOT = (LAS float*)(lds + GL_TOT); LAS float* LA32 = (LAS float*)(lds + GL_LA32); LAS float* EREF = (LAS float*)(lds + GL_EREF); LAS float* ELAST = (LAS float*)(lds + GL_ELAST);
    LAS float* PART = (LAS float*)(lds + GL_PART); LAS float* RS = (LAS float*)(lds + GL_RS);
    const int cb0 = seg * SEGCH; const size_t r00 = (size_t)b * SEQ + (size_t)cb0 * 64;
#define GL_ISSUE_VT(cb_, buf_) do { const bf16* vsrc_ = a.VT + (size_t)(bh * NCH + (cb_)) * 16384; _Pragma("unroll") for (int j_ = 0; j_ < 4; ++j_) { const int B_ = 4 * w + j_, R_ = 8 * B_ + (lane >> 3), c_ = (lane & 7) ^ ((R_ >> 1) & 7); \
        __builtin_amdgcn_global_load_lds((const unsigned*)(vsrc_ + R_ * 64 + c_ * 8), (LAS unsigned*)(lds + GL_VT + (buf_) * 32768 + B_ * 1024), 16, 0, 0); } } while (0)
#define GL_ISSUE_PLR(r0_, buf_) do { _Pragma("unroll") for (int j_ = 0; j_ < 2; ++j_) { const int B_ = 2 * w + j_; \
        __builtin_amdgcn_global_load_lds((const unsigned*)(a.PLR + (r0_) * 16 + B_ * 64 + lane), (LAS unsigned*)(lds + GL_PLR + (buf_) * 4096 + B_ * 256), 4, 0, 0); } } while (0)
#define GL_ISSUE_RAWK(r0_, buf_) do { _Pragma("unroll") for (int j_ = 0; j_ < 2; ++j_) { const int B_ = 2 * w + j_; \
        __builtin_amdgcn_global_load_lds((const unsigned*)(a.K + ((r0_) + 4 * B_ + (lane >> 4)) * 512 + h * 128 + (lane & 15) * 8), (LAS unsigned*)(lds + GL_RAWK + (buf_) * 16384 + B_ * 1024), 16, 0, 0); } } while (0)
    bf16 kraw[16], qraw[16];
    GL_ISSUE_VT(cb0, 0); GL_ISSUE_PLR(r00, 0);
#pragma unroll
    for (int i = 0; i < 16; ++i) { const size_t off = (r00 + 16 * tq + i) * 512 + h * 128 + d; kraw[i] = a.K[off]; qraw[i] = (PASS == 2) ? a.Q[off] : (bf16)0; }
    VMW0(); BARL();
    for (int ci = 0; ci < SEGCH; ++ci) {
        const int cb = cb0 + ci; const size_t r0 = r00 + (size_t)ci * 64; const int vb = ci & 1; const bool more = ci + 1 < SEGCH;
        { const int tb = w & 1, db = w >> 1; const LAS f32x4* ap = (const LAS f32x4*)(lds + GL_PLR + (32 * tb + r) * 64 + 32 * hh);
          const f32x4 p0 = ap[0], p1 = ap[1];
          const unsigned h0 = pk2(p0.x, p0.y), h1 = pk2(p0.z, p0.w), h2 = pk2(p1.x, p1.y), h3 = pk2(p1.z, p1.w);
          const bf16x8 Ah = __builtin_bit_cast(bf16x8, (u32x4){h0, h1, h2, h3});
          const bf16x8 Al = __builtin_bit_cast(bf16x8, (u32x4){pk2(p0.x - bf_lo(h0), p0.y - bf_hi(h0)), pk2(p0.z - bf_lo(h1), p0.w - bf_hi(h1)), pk2(p1.x - bf_lo(h2), p1.y - bf_hi(h2)), pk2(p1.z - bf_lo(h3), p1.w - bf_hi(h3))});
          const bf16x8 Bh = *(const LAS bf16x8*)(lds + GL_WA2 + ((db * 2 + 0) * 64 + lane) * 16), Bl = *(const LAS bf16x8*)(lds + GL_WA2 + ((db * 2 + 1) * 64 + lane) * 16);
          const float bav = BA2[32 * db + r];
          f32x16 Zt;
#pragma unroll
          for (int i = 0; i < 16; ++i) Zt[i] = bav;
          Zt = MFMA32(Ah, Bh, Zt); Zt = MFMA32(Al, Bh, Zt); Zt = MFMA32(Ah, Bl, Zt);
          LAS float* Z = (LAS float*)(lds + GL_VT + (vb ^ 1) * 32768);
#pragma unroll
          for (int i = 0; i < 16; ++i) Z[(32 * tb + (i & 3) + 8 * (i >> 2) + 4 * hh) * 128 + 32 * db + r] = Zt[i]; }
        BARL();
        float bcs[16]; float cs = 0.f;
        { const LAS float* Z = (const LAS float*)(lds + GL_VT + (vb ^ 1) * 32768);
#pragma unroll
          for (int i = 0; i < 16; ++i) { const float z = Z[(16 * tq + i) * 128 + d];
              const float la = (fminf(z, 0.f) - flog(1.0f + fexp(-fabsf(z)))) * (1.0f / 16.0f); cs += la; bcs[i] = cs; } }
        TOT[tq * 128 + d] = cs; if (tq == 2) LA32[d] = bcs[0];
        BARL();
        { const float t0 = TOT[d], t1 = TOT[128 + d], t2 = TOT[256 + d], t3 = TOT[384 + d];
          const float off = (tq > 0 ? t0 : 0.f) + (tq > 1 ? t1 : 0.f) + (tq > 2 ? t2 : 0.f), blast = (t0 + t1) + (t2 + t3), ref = t0 + t1 + LA32[d];
          const float elr = fexp(blast - ref);
          const int dp = (d & ~12) | ((d & 4) << 1) | ((d & 8) >> 1);
          unsigned ktp[8];
#pragma unroll
          for (int i = 0; i < 16; i += 2) {
              const int t = 16 * tq + i;
              const float bt0 = off + bcs[i], bt1 = off + bcs[i + 1]; const float k0 = __uint_as_float((unsigned)kraw[i] << 16), k1 = __uint_as_float((unsigned)kraw[i + 1] << 16);
              const float ek0 = fexp(ref - bt0), ek1 = fexp(ref - bt1);
              ktp[i >> 1] = pk2(k0 * ek0 * elr, k1 * ek1 * elr);
              if (PASS == 2) { const float q0 = __uint_as_float((unsigned)qraw[i] << 16), q1 = __uint_as_float((unsigned)qraw[i + 1] << 16);
                  *(LAS bf16*)(lds + GL_KH + t * 272 + 2 * dp) = (bf16)(pk2(k0 * ek0, 0.f) & 0xffffu); *(LAS bf16*)(lds + GL_KH + (t + 1) * 272 + 2 * dp) = (bf16)(pk2(k1 * ek1, 0.f) & 0xffffu);
                  *(LAS bf16*)(lds + GL_QH + t * 272 + 2 * dp) = (bf16)(pk2(q0 * fexp(bt0 - ref), 0.f) & 0xffffu); *(LAS bf16*)(lds + GL_QH + (t + 1) * 272 + 2 * dp) = (bf16)(pk2(q1 * fexp(bt1 - ref), 0.f) & 0xffffu); }
          }
          *(LAS u32x4*)(lds + GL_KT + d * 144 + 32 * tq) = (u32x4){ktp[0], ktp[1], ktp[2], ktp[3]}; *(LAS u32x4*)(lds + GL_KT + d * 144 + 32 * tq + 16) = (u32x4){ktp[4], ktp[5], ktp[6], ktp[7]};
          if (tq == 0) { ELAST[d] = fexp(blast); if (PASS == 2) EREF[d] = fexp(ref); dsum += blast; } }
        BARL();
        if (more) { GL_ISSUE_VT(cb + 1, vb ^ 1); GL_ISSUE_PLR(r0 + 64, 0);
            if (PASS == 1) {
#pragma unroll
                for (int i = 0; i < 16; ++i) kraw[i] = a.K[(r0 + 64 + 16 * tq + i) * 512 + h * 128 + d];
            } }
        bf16x8 Vf[4];
        { const int R = 32 * w + r, sw = (R >> 1) & 7; const LAS unsigned char* vrow = lds + GL_VT + vb * 32768 + R * 128 + 8 * hh;
#pragma unroll
          for (int s4 = 0; s4 < 4; ++s4) Vf[s4] = frag2p(vrow + (((2 * s4) ^ sw) << 4), vrow + (((2 * s4 + 1) ^ sw) << 4)); }
        f32x16 o0, o1;
        const int cc = tid & 31, rg = tid >> 5;
        u32x4 sgr[4];
        if (PASS == 2) {
#pragma unroll
            for (int i = 0; i < 16; ++i) { o0[i] = 0.f; o1[i] = 0.f; }
            if (w < 3) {
                const int jb = w >> 1, ib = (w + 1) >> 1;
                f32x16 X;
#pragma unroll
                for (int i = 0; i < 16; ++i) X[i] = 0.f;
#pragma unroll
                for (int ks = 0; ks < 8; ++ks) {
                    const bf16x8 Kf = *(const LAS bf16x8*)(lds + GL_KH + (32 * jb + r) * 272 + (16 * ks + 8 * hh) * 2), Qf = *(const LAS bf16x8*)(lds + GL_QH + (32 * ib + r) * 272 + (16 * ks + 8 * hh) * 2);
                    X = MFMA32(Kf, Qf, X);
                }
                if (w != 1) {
#pragma unroll
                    for (int i = 0; i < 16; ++i) { const int j = (i & 3) + 8 * (i >> 2) + 4 * hh; if (j > r) X[i] = 0.f; }
                }
                *(LAS bf16x8*)(lds + GL_PF + ((2 * w) * 64 + lane) * 16) = pack8(X, 0); *(LAS bf16x8*)(lds + GL_PF + ((2 * w + 1) * 64 + lane) * 16) = pack8(X, 1);
            }
            __builtin_amdgcn_sched_barrier(0);
#pragma unroll
            for (int kb = 0; kb < 4; ++kb) {
                f32x16 Ss;
#pragma unroll
                for (int g = 0; g < 4; ++g) { const f32x4 e4 = *(const LAS f32x4*)(EREF + 32 * kb + 8 * g + 4 * hh);
                    Ss[4 * g] = S[kb][4 * g] * e4.x; Ss[4 * g + 1] = S[kb][4 * g + 1] * e4.y; Ss[4 * g + 2] = S[kb][4 * g + 2] * e4.z; Ss[4 * g + 3] = S[kb][4 * g + 3] * e4.w; }
#pragma unroll
                for (int s = 0; s < 2; ++s) { const bf16x8 Sb = pack8(Ss, s); const int ks = 2 * kb + s;
                    const bf16x8 Q0 = *(const LAS bf16x8*)(lds + GL_QH + r * 272 + (16 * ks + 8 * hh) * 2), Q1 = *(const LAS bf16x8*)(lds + GL_QH + (32 + r) * 272 + (16 * ks + 8 * hh) * 2);
                    o0 = MFMA32(Q0, Sb, o0); o1 = MFMA32(Q1, Sb, o1); }
            }
            __builtin_amdgcn_sched_barrier(0);
#pragma unroll
            for (int i = 0; i < 4; ++i) sgr[i] = *(const u32x4*)(a.SG + (r0 + rg + 16 * i) * 1024 + h * 256 + 8 * cc);
            if (more) {
#pragma unroll
                for (int i = 0; i < 16; ++i) { const size_t off = (r0 + 64 + 16 * tq + i) * 512 + h * 128 + d; kraw[i] = a.K[off]; qraw[i] = a.Q[off]; }
            }
            __builtin_amdgcn_sched_barrier(0);
        }
#pragma unroll
        for (int kb = 0; kb < 4; ++kb) {
#pragma unroll
            for (int g = 0; g < 4; ++g) { const f32x4 l4 = *(const LAS f32x4*)(ELAST + 32 * kb + 8 * g + 4 * hh);
                S[kb][4 * g] *= l4.x; S[kb][4 * g + 1] *= l4.y; S[kb][4 * g + 2] *= l4.z; S[kb][4 * g + 3] *= l4.w; }
#pragma unroll
            for (int s4 = 0; s4 < 4; ++s4) { const bf16x8 Af = frag2(lds + GL_KT + (32 * kb + r) * 144 + (16 * s4 + 4 * hh) * 2); S[kb] = MFMA32(Af, Vf[s4], S[kb]); }
        }
        if (PASS == 2) {
            BARL();
            { bf16x8 P[6];
#pragma unroll
              for (int q = 0; q < 6; ++q) P[q] = *(const LAS bf16x8*)(lds + GL_PF + (q * 64 + lane) * 16);
              o0 = MFMA32(P[0], Vf[0], o0); o0 = MFMA32(P[1], Vf[1], o0);
              o1 = MFMA32(P[2], Vf[0], o1); o1 = MFMA32(P[3], Vf[1], o1); o1 = MFMA32(P[4], Vf[2], o1); o1 = MFMA32(P[5], Vf[3], o1); }
            LAS bf16* OT = (LAS bf16*)(lds + GL_OT);
#pragma unroll
            for (int i = 0; i < 16; ++i) { const int row = (i & 3) + 8 * (i >> 2) + 4 * hh; OT[row * 264 + 32 * w + r] = (bf16)(pk2(o0[i], 0.f) & 0xffffu); OT[(32 + row) * 264 + 32 * w + r] = (bf16)(pk2(o1[i], 0.f) & 0xffffu); }
            VMW0();
            BARL();
            const f32x4 gA = *(const f32x4*)(a.g_gla + h * 256 + 8 * cc), gB = *(const f32x4*)(a.g_gla + h * 256 + 8 * cc + 4);
#pragma unroll
            for (int i = 0; i < 4; ++i) { const int row = rg + 16 * i;
                f32x4 oa, ob; pg8::unpk8(*(const LAS u32x4*)(OT + row * 264 + 8 * cc), oa, ob);
                float ss = (oa.x * oa.x + oa.y * oa.y) + (oa.z * oa.z + oa.w * oa.w) + (ob.x * ob.x + ob.y * ob.y) + (ob.z * ob.z + ob.w * ob.w);
                ss += __shfl_xor(ss, 1); ss += __shfl_xor(ss, 2); ss += __shfl_xor(ss, 4); ss += __shfl_xor(ss, 8); ss += __shfl_xor(ss, 16);
                const float rs = rsqrtf(ss * (1.0f / 256.0f) + EPS);
                f32x4 s0, s1; pg8::unpk8(sgr[i], s0, s1);
                pg8::st8(a.O2 + (r0 + row) * 1024 + h * 256 + 8 * cc, oa * rs * gA * s0, ob * rs * gB * s1); }
        } else {
            VMW0(); BARL();
        }
    }
    if (PASS == 1) {
#pragma unroll
        for (int kb = 0; kb < 4; ++kb)
#pragma unroll
            for (int g = 0; g < 4; ++g) *(f32x4*)(est + (size_t)(((w * 4 + kb) * 4 + g) * 64 + lane) * 4) = (f32x4){S[kb][4 * g], S[kb][4 * g + 1], S[kb][4 * g + 2], S[kb][4 * g + 3]};
        if (tq == 0) a.DSEG[item * 128 + d] = __expf(dsum);
    }
    asm volatile("s_waitcnt vmcnt(0) lgkmcnt(0)" ::: "memory"); __syncthreads();
#undef GL_ISSUE_VT
#undef GL_ISSUE_PLR
#undef GL_ISSUE_RAWK
}
DI void p_prefix(int vcu, int tid, float* EST, const float* DSEG) {
    const int gid = vcu * 512 + tid, bh = gid >> 13, qi = gid & 8191, lane_ = qi & 63, g = (qi >> 6) & 3, kb = (qi >> 8) & 3, dk0 = 32 * kb + 8 * g + 4 * (lane_ >> 5);
    f32x4 E[NSEG], Dv[NSEG];
#pragma unroll
    for (int s = 0; s < NSEG; ++s) { E[s] = *(const f32x4*)(EST + ((size_t)(bh * NSEG + s) * 8192 + qi) * 4); Dv[s] = *(const f32x4*)(DSEG + (bh * NSEG + s) * 128 + dk0); }
    f32x4 run = (f32x4){0.f, 0.f, 0.f, 0.f};
#pragma unroll
    for (int s = 0; s < NSEG; ++s) { *(f32x4*)(EST + ((size_t)(bh * NSEG + s) * 8192 + qi) * 4) = run; run = Dv[s] * run + E[s]; }
}

struct Args { const float* in[22]; float* out; unsigned char* ws; int ph_lo, ph_hi, li, pad; };
__global__ void __launch_bounds__(NWAVES * 64, 2) hyb_fwd(Args args) {
    extern __shared__ __attribute__((aligned(16))) unsigned char lds_raw[];
    LAS unsigned char* lds = (LAS unsigned char*)lds_raw;
    volatile LAS unsigned* MISC = (volatile LAS unsigned*)(lds + MISC_OFF);
    const int tid = threadIdx.x, lane = tid & 63, wave = __builtin_amdgcn_readfirstlane(tid >> 6);
    const int G = gridDim.x; const int bx = blockIdx.x; const int vcu = (G % 8 == 0) ? (bx % 8) * (G / 8) + bx / 8 : bx;
    unsigned char* ws = args.ws;
    gu32* ctl = (gu32*)(ws + WS_CTL);
    for (int u = tid; u < (LDS_BYTES - LDSCTL_OFF) / 4; u += NWAVES * 64) ((LAS unsigned*)(lds + LDSCTL_OFF))[u] = 0u;
    __syncthreads();
    XcdBarrier bar; bar.bar = (unsigned*)(ctl + CW_BAR); bar.x = 0; bar.st = nullptr;
    if (N_LAUNCHES == 1) bar = xcd_barrier_post((unsigned*)(ctl + CW_BAR), MISC + 8);
#define GRID_BAR() do { if (N_LAUNCHES == 1) xcd_barrier(bar); } while (0)
    const int lo = args.ph_lo, hi = args.ph_hi;
#ifndef PH_MASK
#define PH_MASK 0xFFF
#endif
#define IN(k) (((PH_MASK >> (k)) & 1) && !((args.pad >> (k)) & 1) && lo <= (k) && (k) < hi)
#define BOTH(k) (IN(k) && IN((k) + 1))
    const float* x = args.in[0];
    float* mod = (float*)(ws + WS_MOD);
    bf16* WLR = (bf16*)(ws + WS_WLR); bf16* W1T = (bf16*)(ws + WS_W1T); bf16* WVT = (bf16*)(ws + WS_WVT); bf16* WCT = (bf16*)(ws + WS_WCT); bf16* WGT = (bf16*)(ws + WS_WGT);
    bf16* WOT = (bf16*)(ws + WS_WOT); bf16* WF1T = (bf16*)(ws + WS_WF1T); bf16* WF2T = (bf16*)(ws + WS_WF2T);
    float* PLR = (float*)(ws + WS_PLR); float* GM2 = (float*)(ws + WS_GM2); float* C1 = (float*)(ws + WS_C1); float* RSS = (float*)(ws + WS_RSS);
    bf16* Ub = (bf16*)(ws + WS_U); bf16* MG = Ub; bf16* H2 = (bf16*)(ws + WS_H2);
    bf16* Qb = (bf16*)(ws + WS_Q); bf16* Kb = (bf16*)(ws + WS_K); bf16* VTb = (bf16*)(ws + WS_VT); bf16* SGb = (bf16*)(ws + WS_SG); bf16* GTb = (bf16*)(ws + WS_GT);
    float* EST = (float*)(ws + WS_EST); float* DSEG = (float*)(ws + WS_DSEG);
    bf16* F1 = (bf16*)(ws + WS_F1);
    bf16* Hb = (bf16*)args.out; bf16* UC = Hb; bf16* O2 = Hb; bf16* GC = (bf16*)((unsigned char*)args.out + OUT_GC);
    float* X1 = args.out;

    if (IN(0)) {
        P0Args a{args.in[1], args.in[2], args.in[3], args.in[5], args.in[11], args.in[16], args.in[17], args.in[19], args.in[20], mod, W1T, WVT, WLR, WCT, WGT, WOT, WF1T, WF2T};
        p0_prologue(lds, vcu, G, tid, lane, wave, a);
        if (BOTH(0)) GRID_BAR();
    }
    if (IN(1)) {
        p_norm<true>(lds, vcu, tid, lane, wave, x, args.in[4], mod, 1024, 0, Hb, WLR, PLR);
#if FUSE_NORM
        p1_tables(lds, vcu, tid, mod, args.in[18], args.in[19], GM2, C1, RSS);
#endif
        if (BOTH(1)) GRID_BAR();
    }
    if (IN(2)) {
        const float qs = 0.08838834764831845f;
        { pg8::Gemm g{Hb, W1T, M, 2048, D}; pg8::StaticOrder S; S.init(M, 2048, G, bx);
          pg8::Epi1<0> E{Ub, nullptr, args.in[6], qs};
          pg8::gemm_phase<pg8::Epi1<0>, pg8::StaticOrder, true, true>(lds + RING_OFF, g, S, E); }
        { pg8::Gemm g{Hb, W1T + (size_t)2048 * D, M, 1024, D}; pg8::StaticOrder S; S.init(M, 1024, G, bx);
          pg8::Epi1<1> E{Qb, Kb, nullptr, qs};
          pg8::gemm_phase<pg8::Epi1<1>, pg8::StaticOrder, true, true>(lds + RING_OFF, g, S, E); }
        { pg8::Gemm g{Hb, W1T + (size_t)3072 * D, M, 1024, D}; pg8::StaticOrder S; S.init(M, 1024, G, bx);
          pg8::Epi1<2> E{SGb, nullptr, nullptr, qs};
          pg8::gemm_phase<pg8::Epi1<2>, pg8::StaticOrder, true, true>(lds + RING_OFF, g, S, E); }
        { pg8::Gemm g{Hb, W1T + (size_t)4096 * D, M, 2048, D}; pg8::StaticOrder S; S.init(M, 2048, G, bx);
          pg8::Epi1<3> E{GTb, nullptr, nullptr, qs};
          pg8::gemm_phase<pg8::Epi1<3>, pg8::StaticOrder, true, true>(lds + RING_OFF, g, S, E); }
        { pg8::Gemm g{WVT, Hb, D, M, D}; pg8::StaticOrder S; S.init(D, M, G, bx);
          pg8::EpiVT E{VTb};
          pg8::gemm_phase<pg8::EpiVT, pg8::StaticOrder, true, true>(lds + RING_OFF, g, S, E); }
        if (BOTH(2)) GRID_BAR();
    }
    if (IN(3)) {
        p_conv(lds, vcu, tid, lane, wave, Ub, args.in[7], args.in[8], args.in[9], args.in[10], UC);
        __syncthreads();
        GlaArgs a{Qb, Kb, VTb, SGb, PLR, args.in[13], args.in[14], args.in[15], EST, DSEG, O2};
        p_gla<1>(lds, vcu, tid, lane, wave, a);
        if (BOTH(3)) GRID_BAR();
    }
    if (IN(4)) {
        p_prefix(vcu, tid, EST, DSEG);
        { pg8::Gemm g{UC, WCT, M, D, D}; pg8::StaticOrder S; S.init(M, D, G, bx);
          pg8::EpiConv E{GC, GTb, args.in[12]};
          pg8::gemm_phase<pg8::EpiConv, pg8::StaticOrder, true, true>(lds + RING_OFF, g, S, E); }
        if (BOTH(4)) GRID_BAR();
    }
    if (IN(5)) {
        GlaArgs a{Qb, Kb, VTb, SGb, PLR, args.in[13], args.in[14], args.in[15], EST, DSEG, O2};
        p_gla<2>(lds, vcu, tid, lane, wave, a);
        if (BOTH(5)) GRID_BAR();
    }
    if (IN(6)) {
        { pg8::Gemm g{O2, WGT, M, D, D}; pg8::StaticOrder S; S.init(M, D, G, bx);
          pg8::EpiGla E{MG, GC, GTb};
          pg8::gemm_phase<pg8::EpiGla, pg8::StaticOrder, true, true>(lds + RING_OFF, g, S, E); }
        if (BOTH(6)) GRID_BAR();
    }
    if (IN(7)) {
        { pg8::Gemm g{MG, WOT, M, D, D}; pg8::StaticOrder S; S.init(M, D, G, bx);
#if FUSE_NORM
          pg8::EpiRes2 E{x, X1, mod + 2048, GM2, H2, RSS};
          pg8::gemm_phase<pg8::EpiRes2, pg8::StaticOrder, true, true>(lds + RING_OFF, g, S, E); }
#else
          pg8::EpiRes E{x, X1, mod + 2048};
          pg8::gemm_phase<pg8::EpiRes, pg8::StaticOrder, true, true>(lds + RING_OFF, g, S, E); }
#endif
        if (BOTH(7)) GRID_BAR();
    }
#if !FUSE_NORM
    if (IN(8)) {
        p_norm<false>(lds, vcu, tid, lane, wave, X1, args.in[18], mod, 4096, 3072, H2, nullptr, nullptr);
        if (BOTH(8)) GRID_BAR();
    }
#endif
    if (IN(9)) {
        { pg8::Gemm g{H2, WF1T, M, FF, D}; pg8::StaticOrder S; S.init(M, FF, G, bx);
#if FUSE_NORM
          pg8::EpiFF1n E{F1, RSS, C1, EPS};
          pg8::gemm_phase<pg8::EpiFF1n, pg8::StaticOrder, true, true>(lds + RING_OFF, g, S, E); }
#else
          pg8::EpiFF1 E{F1};
          pg8::gemm_phase<pg8::EpiFF1, pg8::StaticOrder, true, true>(lds + RING_OFF, g, S, E); }
#endif
        if (BOTH(9)) GRID_BAR();
    }
    if (IN(10)) {
        { pg8::Gemm g{F1, WF2T, M, D, FF}; pg8::StaticOrder S; S.init(M, D, G, bx);
          pg8::EpiRes E{X1, X1, mod + 5120};
          pg8::gemm_phase<pg8::EpiRes, pg8::StaticOrder, true, true>(lds + RING_OFF, g, S, E); }
        if (BOTH(10)) GRID_BAR();
    }
    if (IN(11)) p_final(vcu, lane, wave, X1, args.in[21]);
#undef IN
#undef BOTH
}

extern "C" void kernel_launch(void* const* d_in, const int* in_sizes, int n_in, void* d_out, int out_size, void* d_ws, size_t ws_size, hipStream_t stream) {
    static int grid = 0;
    if (grid == 0) {
        if (n_in != 22 || in_sizes[0] != M * D || out_size != M * D || ws_size < WS_END) { fprintf(stderr, "kernel_launch: shape/workspace mismatch: n_in %d in0 %d out %d ws %zu (need %zu)\n", n_in, n_in > 0 ? in_sizes[0] : -1, out_size, ws_size, (size_t)WS_END); grid = -1; return; }
        int dev = 0, cus = 0, per_cu = 0;
        if (hipGetDevice(&dev) != hipSuccess || hipDeviceGetAttribute(&cus, hipDeviceAttributeMultiprocessorCount, dev) != hipSuccess) { grid = -1; return; }
        if (hipFuncSetAttribute((const void*)hyb_fwd, hipFuncAttributeMaxDynamicSharedMemorySize, LDS_BYTES) != hipSuccess) { fprintf(stderr, "kernel_launch: hipFuncSetAttribute failed\n"); grid = -1; return; }
        if (hipOccupancyMaxActiveBlocksPerMultiprocessor(&per_cu, (const void*)hyb_fwd, NWAVES * 64, LDS_BYTES) != hipSuccess || per_cu < 1) { fprintf(stderr, "kernel_launch: occupancy query says %d blocks per CU\n", per_cu); (void)hipGetLastError(); grid = -1; return; }
        grid = cus;
        if (grid != 256) fprintf(stderr, "kernel_launch: note: %d CUs; the phase program is balanced for 256\n", grid);
    }
    if (grid < 0) return;
    (void)hipMemsetAsync((char*)d_ws + WS_CTL, 0, CTL_ZERO_BYTES, stream);
    Args a{};
    for (int i = 0; i < 22; ++i) a.in[i] = (const float*)d_in[i];
    a.out = (float*)d_out; a.ws = (unsigned char*)d_ws;
#ifdef PROBE_SKIP
    {
        a.ph_lo = 0; a.ph_hi = N_PHASES; a.li = 0; a.pad = PROBE_SKIP;
        void* kargs0[] = {&a};
        (void)hipLaunchCooperativeKernel((const void*)hyb_fwd, dim3(grid), dim3(NWAVES * 64), kargs0, LDS_BYTES, stream);
        (void)hipMemsetAsync((char*)d_ws + WS_CTL, 0, CTL_ZERO_BYTES, stream);
        a.pad = 0;
    }
#endif
#ifdef PROBE_PRE
    {
        a.ph_lo = 0; a.ph_hi = PROBE_PRE; a.li = 0;
        void* kargs0[] = {&a};
        (void)hipLaunchCooperativeKernel((const void*)hyb_fwd, dim3(grid), dim3(NWAVES * 64), kargs0, LDS_BYTES, stream);
        (void)hipMemsetAsync((char*)d_ws + WS_CTL, 0, CTL_ZERO_BYTES, stream);
    }
#endif
    if (N_LAUNCHES == 1) {
        a.ph_lo = 0; a.ph_hi = N_PHASES; a.li = 0;
        void* kargs[] = {&a};
        hipError_t e = hipLaunchCooperativeKernel((const void*)hyb_fwd, dim3(grid), dim3(NWAVES * 64), kargs, LDS_BYTES, stream);
        if (e != hipSuccess) fprintf(stderr, "kernel_launch: cooperative launch failed: %s (grid %d)\n", hipGetErrorString(e), grid);
    } else {
        for (int li = 0; li < N_PHASES; ++li) { a.ph_lo = li; a.ph_hi = li + 1; a.li = li; hipLaunchKernelGGL(hyb_fwd, dim3(grid), dim3(NWAVES * 64), LDS_BYTES, stream, a); }
    }
}
```
